# Optimizing an MI355X kernel written in HIP

```python
import math, functools
import jax, jax.numpy as jnp
from jax import lax
import numpy as np

D_MODEL = 1024
BATCH = 2
SEQ = 16384
DEPTH = 2
DEC_BATCH = 16
DEC_SEQ = 32
PAST_LEN = 1024

CHUNK = 64
HEAD_DIM = 64
A_HEADS = 8
A_PREV_CHUNKS = 8
A_BAND = A_PREV_CHUNKS * CHUNK
A_REL_CLIP = 128
B_Q_HEADS = 8
B_KV_HEADS = 2
B_GROUP = B_Q_HEADS // B_KV_HEADS
B_WINDOW = 128
B_PREV_CHUNKS = B_WINDOW // CHUNK
T5_BUCKETS = 32
T5_MAX_DIST = 128
C_HEADS = 16
C_Q_LORA = 384
C_KV_LORA = 256
C_NOPE = 64
C_ROPE = 32
C_V = 64
ROPE_BASE = 10000.0
MLA_Q_BLOCK = 128
D_FF = 2816
N_EVEN = (DEPTH + 1) // 2
N_ODD = DEPTH // 2
EPS = 1e-6
NEG = -1e30
A_W = A_HEADS * HEAD_DIM
BQ_W = B_Q_HEADS * HEAD_DIM
BKV_W = B_KV_HEADS * HEAD_DIM
AB_SPLITS = (A_W, 2 * A_W, 3 * A_W, 3 * A_W + BQ_W, 3 * A_W + BQ_W + BKV_W)
AB_WIDTH = 3 * A_W + BQ_W + 2 * BKV_W
AB_OUT = A_W + BQ_W
C_IN_WIDTH = C_Q_LORA + C_KV_LORA + C_ROPE

kernel_name = "hybrid_chunk_streaming_encoder_step"


def rmsnorm(x, g):
    xf = x.astype(jnp.float32)
    y = xf * lax.rsqrt(jnp.mean(xf * xf, axis=-1, keepdims=True) + EPS)
    return (y * g.astype(jnp.float32)).astype(x.dtype)


def modulate(h, shift, scale):
    return h * (1 + scale[:, None, :]) + shift[:, None, :]


def swiglu(h, wg, wu, wd):
    return (jax.nn.silu(h @ wg) * (h @ wu)) @ wd


def attend(q, k, v, bias=None, mask=None, sink=None):
    scale = q.shape[-1] ** -0.5
    s = jnp.einsum('...qhgd,...khd->...hgqk', q, k).astype(jnp.float32) * scale
    if bias is not None:
        s = s + bias
    if mask is not None:
        s = jnp.where(mask, s, NEG)
    m = jnp.max(s, axis=-1, keepdims=True)
    if sink is not None:
        sk = sink.astype(jnp.float32)[:, :, None, None]
        m = jnp.maximum(m, sk)
    p = jnp.exp(s - m)
    den = jnp.sum(p, axis=-1, keepdims=True)
    if sink is not None:
        den = den + jnp.exp(sk - m)
    p = (p / den).astype(v.dtype)
    return jnp.einsum('...hgqk,...khd->...qhgd', p, v)


def chunk_band(t, n_prev):
    b, s, h, d = t.shape
    nc = s // CHUNK
    tp = jnp.pad(t.reshape(b, nc, CHUNK, h, d), ((0, 0), (n_prev, 0), (0, 0), (0, 0), (0, 0)))
    band = jnp.stack([tp[:, i:i + nc] for i in range(n_prev + 1)], axis=2)
    return band.reshape(b, nc, (n_prev + 1) * CHUNK, h, d)


def band_mask(nc, n_prev):
    kb = (n_prev + 1) * CHUNK
    valid = (jnp.arange(nc)[:, None] - n_prev + jnp.arange(kb)[None, :] // CHUNK) >= 0
    return valid.reshape(nc, 1, 1, 1, kb)


def band_rel(n_prev):
    return jnp.arange((n_prev + 1) * CHUNK)[None, :] - n_prev * CHUNK - jnp.arange(CHUNK)[:, None]


def stream_rel(n_cache, t):
    return jnp.arange(n_cache + t)[None, :] - n_cache - jnp.arange(t)[:, None]


def clipped_bias(table, rel):
    idx = jnp.clip(rel, -A_REL_CLIP, A_REL_CLIP) + A_REL_CLIP
    return jnp.transpose(table[idx].astype(jnp.float32), (2, 0, 1))[:, None]


def t5_bucket(rel):
    nb = T5_BUCKETS // 2
    ret = jnp.where(rel > 0, nb, 0)
    n = jnp.abs(rel)
    max_exact = nb // 2
    large = max_exact + (jnp.log(jnp.maximum(n, 1).astype(jnp.float32) / max_exact)
                         / math.log(T5_MAX_DIST / max_exact) * (nb - max_exact)).astype(jnp.int32)
    large = jnp.minimum(large, nb - 1)
    return ret + jnp.where(n < max_exact, n, large)


def t5_bias_fn(table, rel):
    tq, tk = rel.shape
    b = table[t5_bucket(rel)].astype(jnp.float32)
    return jnp.transpose(b, (2, 0, 1)).reshape(B_KV_HEADS, B_GROUP, tq, tk)


def rope(x, pos):
    half = x.shape[-1] // 2
    inv = ROPE_BASE ** (-jnp.arange(half, dtype=jnp.float32) / half)
    ang = pos.astype(jnp.float32)[:, None] * inv[None, :]
    cos = jnp.cos(ang)[:, None, :]
    sin = jnp.sin(ang)[:, None, :]
    xf = x.astype(jnp.float32)
    x1, x2 = xf[..., :half], xf[..., half:]
    return jnp.concatenate([x1 * cos - x2 * sin, x1 * sin + x2 * cos], axis=-1).astype(x.dtype)


def heads_ab(h, w_in):
    b, t, _ = h.shape
    qa, ka, va, qb, kb, vb = jnp.split(h @ w_in, AB_SPLITS, axis=-1)
    r = lambda z, n: z.reshape(b, t, n, HEAD_DIM)
    return (r(qa, A_HEADS), r(ka, A_HEADS), r(va, A_HEADS),
            r(qb, B_Q_HEADS), r(kb, B_KV_HEADS), r(vb, B_KV_HEADS))


def mixer_ab_prompt(h, w_in, w_out, rel_tab, t5_tab, sinks):
    b, s, _ = h.shape
    nc = s // CHUNK
    qa, ka, va, qb, kb, vb = heads_ab(h, w_in)
    oa = attend(qa.reshape(b, nc, CHUNK, A_HEADS, 1, HEAD_DIM),
                chunk_band(ka, A_PREV_CHUNKS), chunk_band(va, A_PREV_CHUNKS),
                bias=clipped_bias(rel_tab, band_rel(A_PREV_CHUNKS)),
                mask=band_mask(nc, A_PREV_CHUNKS))
    ob = attend(qb.reshape(b, nc, CHUNK, B_KV_HEADS, B_GROUP, HEAD_DIM),
                chunk_band(kb, B_PREV_CHUNKS), chunk_band(vb, B_PREV_CHUNKS),
                bias=t5_bias_fn(t5_tab, band_rel(B_PREV_CHUNKS)),
                mask=band_mask(nc, B_PREV_CHUNKS),
                sink=sinks.reshape(B_KV_HEADS, B_GROUP))
    y = jnp.concatenate([oa.reshape(b, s, A_W), ob.reshape(b, s, BQ_W)], axis=-1) @ w_out
    la, lb = min(A_BAND, s), min(B_WINDOW, s)
    return y, (ka[:, s - la:], va[:, s - la:], kb[:, s - lb:], vb[:, s - lb:])


def mixer_ab_sample(h, cak, cav, cbk, cbv, w_in, w_out, rel_tab, t5_tab, sinks):
    b, t, _ = h.shape
    qa, ka, va, qb, kb, vb = heads_ab(h, w_in)
    la = cak.shape[1]
    oa = attend(qa[:, :, :, None], jnp.concatenate([cak, ka], axis=1), jnp.concatenate([cav, va], axis=1),
                bias=clipped_bias(rel_tab, stream_rel(la, t)))
    lb = cbk.shape[1]
    ob = attend(qb.reshape(b, t, B_KV_HEADS, B_GROUP, HEAD_DIM),
                jnp.concatenate([cbk, kb], axis=1), jnp.concatenate([cbv, vb], axis=1),
                bias=t5_bias_fn(t5_tab, stream_rel(lb, t)),
                sink=sinks.reshape(B_KV_HEADS, B_GROUP))
    y = jnp.concatenate([oa.reshape(b, t, A_W), ob.reshape(b, t, BQ_W)], axis=-1) @ w_out
    return y, (ka, va, kb, vb)


def mla_project(h, pos, w_in, qn_g, kvn_g, w_qb):
    b, t, _ = h.shape
    q_lat, kv_lat, k_r = jnp.split(h @ w_in, (C_Q_LORA, C_Q_LORA + C_KV_LORA), axis=-1)
    q = (rmsnorm(q_lat, qn_g) @ w_qb).reshape(b, t, C_HEADS, C_NOPE + C_ROPE)
    q = jnp.concatenate([q[..., :C_NOPE], rope(q[..., C_NOPE:], pos)], axis=-1)
    kv_lat = rmsnorm(kv_lat, kvn_g)
    k_r = rope(k_r[:, :, None, :], pos)[:, :, 0]
    return q, kv_lat, k_r


def mla_keys(kv_lat, k_r, w_kvb):
    b, l, _ = kv_lat.shape
    kv = (kv_lat @ w_kvb).reshape(b, l, C_HEADS, C_NOPE + C_V)
    k = jnp.concatenate([kv[..., :C_NOPE], jnp.broadcast_to(k_r[:, :, None, :], (b, l, C_HEADS, C_ROPE))], axis=-1)
    return k, kv[..., C_NOPE:]


def mixer_c_prompt(h, w_in, qn_g, kvn_g, w_qb, w_kvb, w_out):
    b, s, _ = h.shape
    q, kv_lat, k_r = mla_project(h, jnp.arange(s), w_in, qn_g, kvn_g, w_qb)
    k, v = mla_keys(kv_lat, k_r, w_kvb)
    nb = s // MLA_Q_BLOCK
    qb = q.reshape(b, nb, MLA_Q_BLOCK, C_HEADS, 1, C_NOPE + C_ROPE).transpose(1, 0, 2, 3, 4, 5)
    kchunk = jnp.arange(s) // CHUNK

    def block(args):
        qi, i = args
        qchunk = (i * MLA_Q_BLOCK + jnp.arange(MLA_Q_BLOCK)) // CHUNK
        return attend(qi, k, v, mask=kchunk[None, :] <= qchunk[:, None])

    o = lax.map(block, (qb, jnp.arange(nb)))
    o = o.transpose(1, 0, 2, 3, 4, 5).reshape(b, s, C_HEADS * C_V)
    return o @ w_out, (kv_lat, k_r)


def mixer_c_sample(h, ckv, ckr, w_in, qn_g, kvn_g, w_qb, w_kvb, w_out):
    b, t, _ = h.shape
    past = ckv.shape[1]
    q, kv_lat, k_r = mla_project(h, past + jnp.arange(t), w_in, qn_g, kvn_g, w_qb)
    k, v = mla_keys(jnp.concatenate([ckv, kv_lat], axis=1), jnp.concatenate([ckr, k_r], axis=1), w_kvb)
    o = attend(q[:, :, :, None], k, v).reshape(b, t, C_HEADS * C_V)
    return o @ w_out, (kv_lat, k_r)


def macaron_layer(x, c, mix, w_ada_l, b_ada_l, norm_g_l, wg, wu, wd):
    mods = jnp.split(jax.nn.silu(c) @ w_ada_l + b_ada_l, 9, axis=-1)
    h = modulate(rmsnorm(x, norm_g_l[0]), mods[0], mods[1])
    x = x + 0.5 * mods[2][:, None, :] * swiglu(h, wg[0], wu[0], wd[0])
    h = modulate(rmsnorm(x, norm_g_l[1]), mods[3], mods[4])
    y, st = mix(h)
    x = x + mods[5][:, None, :] * y
    h = modulate(rmsnorm(x, norm_g_l[2]), mods[6], mods[7])
    x = x + 0.5 * mods[8][:, None, :] * swiglu(h, wg[1], wu[1], wd[1])
    return x, st


def setup_inputs(seed: int = 0) -> dict:
    key = jax.random.key(seed)
    ks = iter(jax.random.split(key, 40))
    nrm = lambda shape, s=1.0: jax.random.normal(next(ks), shape, jnp.float32) * s
    la, lb = min(A_BAND, PAST_LEN), min(B_WINDOW, PAST_LEN)
    return {
        "x_prompt": nrm((BATCH, SEQ, D_MODEL)),
        "x_sample": nrm((DEC_BATCH, DEC_SEQ, D_MODEL)),
        "c_prompt": nrm((BATCH, D_MODEL)),
        "c_sample": nrm((DEC_BATCH, D_MODEL)),
        "cache_a_k": nrm((N_EVEN, DEC_BATCH, la, A_HEADS, HEAD_DIM)),
        "cache_a_v": nrm((N_EVEN, DEC_BATCH, la, A_HEADS, HEAD_DIM)),
        "cache_b_k": nrm((N_EVEN, DEC_BATCH, lb, B_KV_HEADS, HEAD_DIM)),
        "cache_b_v": nrm((N_EVEN, DEC_BATCH, lb, B_KV_HEADS, HEAD_DIM)),
        "cache_c_kv": nrm((N_ODD, DEC_BATCH, PAST_LEN, C_KV_LORA)),
        "cache_c_kr": nrm((N_ODD, DEC_BATCH, PAST_LEN, C_ROPE)),
        "w_ada": nrm((DEPTH, D_MODEL, 9 * D_MODEL), 0.3 * D_MODEL ** -0.5),
        "b_ada": nrm((DEPTH, 9 * D_MODEL), 0.02),
        "norm_g": 1.0 + nrm((DEPTH, 3, D_MODEL), 0.02),
        "final_norm_g": 1.0 + nrm((D_MODEL,), 0.02),
        "ffn_w_gate": nrm((DEPTH, 2, D_MODEL, D_FF), D_MODEL ** -0.5),
        "ffn_w_up": nrm((DEPTH, 2, D_MODEL, D_FF), D_MODEL ** -0.5),
        "ffn_w_down": nrm((DEPTH, 2, D_FF, D_MODEL), D_FF ** -0.5),
        "w_in_ab": nrm((N_EVEN, D_MODEL, AB_WIDTH), D_MODEL ** -0.5),
        "w_out_ab": nrm((N_EVEN, AB_OUT, D_MODEL), AB_OUT ** -0.5),
        "rel_bias_a": nrm((N_EVEN, 2 * A_REL_CLIP + 1, A_HEADS), 0.1),
        "t5_bias": nrm((T5_BUCKETS, B_Q_HEADS), 0.1),
        "sinks_b": nrm((N_EVEN, B_Q_HEADS), 0.5),
        "w_in_c": nrm((N_ODD, D_MODEL, C_IN_WIDTH), D_MODEL ** -0.5),
        "c_q_norm_g": 1.0 + nrm((N_ODD, C_Q_LORA), 0.02),
        "c_kv_norm_g": 1.0 + nrm((N_ODD, C_KV_LORA), 0.02),
        "w_qb": nrm((N_ODD, C_Q_LORA, C_HEADS * (C_NOPE + C_ROPE)), C_Q_LORA ** -0.5),
        "w_kvb": nrm((N_ODD, C_KV_LORA, C_HEADS * (C_NOPE + C_V)), C_KV_LORA ** -0.5),
        "w_out_c": nrm((N_ODD, C_HEADS * C_V, D_MODEL), (C_HEADS * C_V) ** -0.5),
    }


def reference(x_prompt, x_sample, c_prompt, c_sample, cache_a_k, cache_a_v, cache_b_k, cache_b_v,
              cache_c_kv, cache_c_kr, w_ada, b_ada, norm_g, final_norm_g, ffn_w_gate, ffn_w_up, ffn_w_down,
              w_in_ab, w_out_ab, rel_bias_a, t5_bias, sinks_b, w_in_c, c_q_norm_g, c_kv_norm_g, w_qb, w_kvb,
              w_out_c):
    xp, xs = x_prompt, x_sample
    ab_p, ab_s, c_p, c_s = [], [], [], []
    for l in range(DEPTH):
        lw = (w_ada[l], b_ada[l], norm_g[l], ffn_w_gate[l], ffn_w_up[l], ffn_w_down[l])
        if l % 2 == 0:
            e = l // 2
            shared = dict(w_in=w_in_ab[e], w_out=w_out_ab[e], rel_tab=rel_bias_a[e], t5_tab=t5_bias, sinks=sinks_b[e])
            mix_p = functools.partial(mixer_ab_prompt, **shared)
            mix_s = functools.partial(mixer_ab_sample, cak=cache_a_k[e], cav=cache_a_v[e],
                                      cbk=cache_b_k[e], cbv=cache_b_v[e], **shared)
            xp, st = macaron_layer(xp, c_prompt, mix_p, *lw)
            ab_p.append(st)
            xs, st = macaron_layer(xs, c_sample, mix_s, *lw)
            ab_s.append(st)
        else:
            o = l // 2
            shared = dict(w_in=w_in_c[o], qn_g=c_q_norm_g[o], kvn_g=c_kv_norm_g[o], w_qb=w_qb[o],
                          w_kvb=w_kvb[o], w_out=w_out_c[o])
            mix_p = functools.partial(mixer_c_prompt, **shared)
            mix_s = functools.partial(mixer_c_sample, ckv=cache_c_kv[o], ckr=cache_c_kr[o], **shared)
            xp, st = macaron_layer(xp, c_prompt, mix_p, *lw)
            c_p.append(st)
            xs, st = macaron_layer(xs, c_sample, mix_s, *lw)
            c_s.append(st)
    y_prompt = rmsnorm(xp, final_norm_g)
    y_sample = rmsnorm(xs, final_norm_g)
    stk = lambda lst, i: jnp.stack([st[i] for st in lst], axis=0)
    return (y_prompt, y_sample,
            stk(ab_p, 0), stk(ab_p, 1), stk(ab_p, 2), stk(ab_p, 3), stk(c_p, 0), stk(c_p, 1),
            stk(ab_s, 0), stk(ab_s, 1), stk(ab_s, 2), stk(ab_s, 3), stk(c_s, 0), stk(c_s, 1))
```

```cpp
#include <hip/hip_runtime.h>
#include <hip/hip_cooperative_groups.h>
#include <cstdio>
#include <cstdint>
namespace cg = cooperative_groups;

constexpr int DM = 1024, SEQ = 16384, NPROMPT = 2 * SEQ, NSAMP = 16 * 32, R = NPROMPT + NSAMP;
constexpr int DFF = 2816, NSEQ = 18, NMOD = 9 * DM;
constexpr int LA = 512, LB = 128, PAST = 1024;
constexpr int KA_ROWS = NPROMPT + 16 * (LA + 32);
constexpr int KB_ROWS = NPROMPT + 16 * (LB + 32);
constexpr int RKV = NPROMPT + 16 * (PAST + 32);
constexpr int LUTN = 1280, LUT0 = 640;
constexpr float LOG2E = 1.4426950408889634f;
constexpr float EPS = 1e-6f;

constexpr size_t O_YP = 0, O_YS = O_YP + (size_t)NPROMPT * DM, O_AKP = O_YS + (size_t)NSAMP * DM, O_AVP = O_AKP + 2 * 512 * 512,
                 O_BKP = O_AVP + 2 * 512 * 512, O_BVP = O_BKP + 2 * 128 * 128, O_CKVP = O_BVP + 2 * 128 * 128, O_CKRP = O_CKVP + (size_t)NPROMPT * 256,
                 O_AKS = O_CKRP + (size_t)NPROMPT * 32, O_AVS = O_AKS + 512 * 512, O_BKS = O_AVS + 512 * 512, O_BVS = O_BKS + 512 * 128,
                 O_CKVS = O_BVS + 512 * 128, O_CKRS = O_CKVS + 512 * 256, O_END = O_CKRS + 512 * 32;
static_assert(O_END == 45432832, "d_out size");

constexpr size_t al256(size_t x) { return (x + 255) & ~(size_t)255; }
constexpr size_t SZ_WGU = (size_t)2 * DFF * DM * 2, SZ_WD = (size_t)DM * DFF * 2;
constexpr size_t WS_WGU = 0;
constexpr size_t WS_WD = WS_WGU + 4 * SZ_WGU;
constexpr size_t WS_WAB = WS_WD + 4 * SZ_WD;
constexpr size_t WS_WOAB = WS_WAB + (size_t)2304 * 1024 * 2;
constexpr size_t WS_WCIN = WS_WOAB + (size_t)1024 * 1024 * 2;
constexpr size_t WS_WQB = WS_WCIN + (size_t)768 * 1024 * 2;
constexpr size_t WS_WKVB = WS_WQB + (size_t)1536 * 384 * 2;
constexpr size_t WS_WOC = WS_WKVB + (size_t)2048 * 256 * 2;
constexpr size_t WS_MODS = WS_WOC + (size_t)1024 * 1024 * 2;
constexpr size_t WS_ROPE = WS_MODS + (size_t)2 * NSEQ * NMOD * 4;
constexpr size_t WS_LUTA = WS_ROPE + (size_t)SEQ * 32 * 4;
constexpr size_t WS_LUTB = WS_LUTA + (size_t)8 * LUTN * 4;
constexpr size_t WS_H = al256(WS_LUTB + (size_t)8 * LUTN * 4);
constexpr size_t WS_OV = al256(WS_H + (size_t)(R + 64) * DM * 2);
constexpr size_t WS_HID = WS_OV;
constexpr size_t WS_PART = al256(WS_HID + (size_t)R * DFF * 2);
constexpr size_t WS_Q0 = WS_OV;
constexpr size_t WS_KA = al256(WS_Q0 + (size_t)(R + 64) * 1024 * 2);
constexpr size_t WS_VA = al256(WS_KA + (size_t)(KA_ROWS + 64) * 512 * 2);
constexpr size_t WS_KB = al256(WS_VA + (size_t)(KA_ROWS + 64) * 512 * 2);
constexpr size_t WS_VB = al256(WS_KB + (size_t)(KB_ROWS + 64) * 128 * 2);
constexpr size_t WS_L0END = al256(WS_VB + (size_t)(KB_ROWS + 64) * 128 * 2);
constexpr size_t WS_QN = WS_OV;
constexpr size_t WS_KVN = al256(WS_QN + (size_t)R * 384 * 2);
constexpr size_t WS_KR = al256(WS_KVN + (size_t)RKV * 256 * 2);
constexpr size_t WS_QC = al256(WS_KR + (size_t)(RKV + 64) * 32 * 2);
constexpr size_t WS_KC = al256(WS_QC + (size_t)(R + 64) * 1536 * 2);
constexpr size_t SZ_KC = (size_t)(RKV + 64) * 1024 * 2 > (size_t)R * 768 * 4 ? (size_t)(RKV + 64) * 1024 * 2 : (size_t)R * 768 * 4;
constexpr size_t WS_CIN = WS_KC;
constexpr size_t WS_VC = al256(WS_KC + SZ_KC);
constexpr size_t WS_L1END = al256(WS_VC + (size_t)(RKV + 64) * 1024 * 2);
constexpr size_t WS_TOTAL = WS_L1END > WS_L0END ? WS_L1END : WS_L0END;
static_assert(WS_PART + (size_t)11 * NSAMP * DM * 4 <= WS_TOTAL && WS_PART >= WS_L0END && WS_PART >= WS_QC, "hid + partials fit; partials clear of the layer-0 buffers and of QN/KVN/KR");
constexpr size_t WS_CTL = WS_TOTAL;
static_assert(WS_CTL + 16384 <= (size_t)512 * 1024 * 1024, "workspace fits 4x largest tensor");

__device__ __forceinline__ int tidx_from(int wv);
namespace pg8 {
#define PG8_LAS __attribute__((address_space(3)))
typedef unsigned short bf16_t;
typedef short bf16x8 __attribute__((ext_vector_type(8)));
typedef float f32x4 __attribute__((ext_vector_type(4)));
typedef unsigned u32x4 __attribute__((ext_vector_type(4)));
constexpr int BM = 256, BK = 64, HALF = 128, HTB = HALF * BK * 2  , STAGE_BYTES = 8 * HTB, NXCD = 8, WGM = 8;

__host__ __device__ __forceinline__ int lds_byte(int r, int c) { const int st = (r >> 4) * 2 + (c >> 5), rr = r & 15, cc = c & 31, ob = rr * 64 + cc * 2; return st * 1024 + (ob ^ (((ob >> 9) & 1) << 5)); }
__host__ __device__ __forceinline__ void stage_rc(int b, int& R, int& C) { const int st = b / 1024, sb = b % 1024, swz = sb ^ (((sb >> 9) & 1) << 5); R = (st >> 1) * 16 + swz / 64; C = (st & 1) * 32 + (swz % 64) / 2; }
__host__ __device__ __forceinline__ int perm32(int rho) { const int n = rho >> 4, i = rho & 15; return 8 * (i >> 2) + 4 * n + (i & 3); }

struct Unit { int pm, pn; };
struct Gemm { const bf16_t* A; const bf16_t* Bt; int M, N, K; };

struct StaticOrder {
    int nM, nN, nwg, G, c, kt, ntail, nsplit, ktper;
    __host__ __device__ __forceinline__ void init(int M, int N, int K, int G_, int c_, int Mfull = -1, int nsplit_ = 1) { if (Mfull < 0) Mfull = M; nM = Mfull / BM; nN = N / BM; nwg = nM * nN; G = G_; c = c_; kt = K / BK;
        ntail = ((M - Mfull) / BM) * nN; nsplit = nsplit_; ktper = kt / nsplit_; }
    __host__ __device__ __forceinline__ bool next(int i, Unit& u) const {
        const long L = (long)i * G + c;
        if (L >= nwg) { const long e = L - nwg; if (e >= (long)ntail * nsplit) return false; const int tu = (int)(e / nsplit), sl = (int)(e % nsplit);
            u.pm = (nM + tu / nN) | ((sl + 1) << 12); u.pn = tu % nN; return true; }
        int wgid = (int)L; { const int q = nwg / NXCD, r = nwg % NXCD, xcd = wgid % NXCD, off = wgid / NXCD; wgid = (xcd < r ? xcd * (q + 1) : r * (q + 1) + (xcd - r) * q) + off; }
        const int nig = WGM * nN, gid = wgid / nig, fm = gid * WGM, gsz = (nM - fm) < WGM ? (nM - fm) : WGM;
        u.pm = fm + ((wgid % nig) % gsz); u.pn = (wgid % nig) / gsz; return true;
    }
    __device__ __forceinline__ int k0_of(const Unit& u) const { const int s = u.pm >> 12; return s ? (s - 1) * ktper : 0; }
    __device__ __forceinline__ int nt_of(const Unit& u) const { return (u.pm >> 12) ? ktper : kt; }
    __device__ __forceinline__ void a_ready(const Unit&) const {}
    __device__ __forceinline__ void done(const Unit&) const {}
};

__device__ __forceinline__ unsigned cvt_pk_bf16(float lo, float hi) { unsigned r; asm volatile("v_cvt_pk_bf16_f32 %0, %1, %2" : "=v"(r) : "v"(lo), "v"(hi)); return r; }
typedef unsigned u32x2 __attribute__((ext_vector_type(2)));
__device__ __forceinline__ int cidx_of(int r) { return r < NPROMPT ? (r >> 14) : 2 + ((r - NPROMPT) >> 5); }
__device__ __forceinline__ float silu_f(float x) { return x * __builtin_amdgcn_rcpf(1.0f + __expf(-x)); }
__device__ __forceinline__ u32x4 pack8(const f32x4& a, const f32x4& b) { u32x4 w; w.x = cvt_pk_bf16(a[0], a[1]); w.y = cvt_pk_bf16(a[2], a[3]); w.z = cvt_pk_bf16(b[0], b[1]); w.w = cvt_pk_bf16(b[2], b[3]); return w; }

struct EpiGU {
    static constexpr bool PERM = true, AFTER_DRAIN = false;
    bf16_t* HID;
    __device__ __forceinline__ void operator()(const f32x4 (&acc)[2][2][4][2], const Unit& u, int wr, int wc, int fr, int fq) const {
        { int l_; asm volatile("v_mbcnt_lo_u32_b32 %0, -1, 0\n\tv_mbcnt_hi_u32_b32 %0, -1, %0" : "=v"(l_)); fr = l_ & 15; fq = (l_ >> 4) & 3; }
        const int row0 = u.pm * BM + wr * 64 + fr, col0 = u.pn * 128 + wc * 32 + 8 * fq;
#pragma unroll
        for (int ai = 0; ai < 2; ++ai)
#pragma unroll
            for (int m = 0; m < 4; ++m) {
                f32x4 h0, h1;
#pragma unroll
                for (int j = 0; j < 4; ++j) { h0[j] = silu_f(acc[ai][0][m][0][j]) * acc[ai][1][m][0][j]; h1[j] = silu_f(acc[ai][0][m][1][j]) * acc[ai][1][m][1][j]; }
                *(u32x4*)(HID + (size_t)(row0 + ai * HALF + m * 16) * DFF + col0) = pack8(h0, h1);
            }
    }
};
struct EpiRes {
    static constexpr bool PERM = false, AFTER_DRAIN = false;
    float* X; unsigned char* ws; const float* Xin; int goff_l; float fac;
    __device__ __forceinline__ void operator()(const f32x4 (&acc)[2][2][4][2], const Unit& u, int wr, int wc, int fr, int fq) const {
        { int l_; asm volatile("v_mbcnt_lo_u32_b32 %0, -1, 0\n\tv_mbcnt_hi_u32_b32 %0, -1, %0" : "=v"(l_)); fr = l_ & 15; fq = (l_ >> 4) & 3; }
        const int slice = u.pm >> 12, row0 = (u.pm & 4095) * BM + wr * 64 + fr, col0 = u.pn * BM + wc * 32 + 4 * fq;
        const float* mods = (const float*)(ws + WS_MODS) + (size_t)(goff_l >> 16) * NSEQ * NMOD; const int goff = goff_l & 0xffff; float* PART = (float*)(ws + WS_PART);
#pragma unroll
        for (int ai = 0; ai < 2; ++ai)
#pragma unroll
            for (int mp = 0; mp < 4; mp += 2) {
                f32x4 gv[2][4], xv[2][4];
#pragma unroll
                for (int mm = 0; mm < 2; ++mm) {
                    const int row = row0 + ai * HALF + (mp + mm) * 16; const float* gp = mods + (size_t)cidx_of(row) * NMOD + goff + col0;
                    const float* xs = ((Xin && row < NPROMPT) ? Xin + (size_t)row * DM : X + (size_t)row * DM) + col0;
#pragma unroll
                    for (int q4 = 0; q4 < 4; ++q4) { const int co = (q4 >> 1) * HALF + (q4 & 1) * 16; gv[mm][q4] = *(const f32x4*)(gp + co); if (!slice) xv[mm][q4] = *(const f32x4*)(xs + co); }
                }
#pragma unroll
                for (int mm = 0; mm < 2; ++mm) {
                    const int row = row0 + ai * HALF + (mp + mm) * 16;
#pragma unroll
                    for (int q4 = 0; q4 < 4; ++q4) { const int co = (q4 >> 1) * HALF + (q4 & 1) * 16; const f32x4 d = (gv[mm][q4] * fac) * acc[ai][q4 >> 1][mp + mm][q4 & 1];
                        if (slice) *(f32x4*)(PART + ((size_t)(slice - 1) * NSAMP + (row - NPROMPT)) * DM + col0 + co) = d;
                        else *(f32x4*)(X + (size_t)row * DM + col0 + co) = xv[mm][q4] + d; }
                }
                asm volatile("" ::: "memory");
            }
    }
};
struct EpiQKV {
    static constexpr bool PERM = true, AFTER_DRAIN = false;
    bf16_t *Q0, *KA, *VA, *KB, *VB; float* out;
    __device__ __forceinline__ void operator()(const f32x4 (&acc)[2][2][4][2], const Unit& u, int wr, int wc, int fr, int fq) const {
        { int l_; asm volatile("v_mbcnt_lo_u32_b32 %0, -1, 0\n\tv_mbcnt_hi_u32_b32 %0, -1, %0" : "=v"(l_)); fr = l_ & 15; fq = (l_ >> 4) & 3; }
        const int row0 = u.pm * BM + wr * 64 + fr;
#pragma unroll
        for (int bj = 0; bj < 2; ++bj) {
            const int cbase = u.pn * BM + bj * HALF, reg = cbase >> 7, cw = wc * 32 + 8 * fq;
#pragma unroll
            for (int ai = 0; ai < 2; ++ai)
#pragma unroll
                for (int m = 0; m < 4; ++m) {
                    const int row = row0 + ai * HALF + m * 16; const f32x4 v0 = acc[ai][bj][m][0], v1 = acc[ai][bj][m][1]; const u32x4 w = pack8(v0, v1);
                    const bool isp = row < NPROMPT; const int b = isp ? (row >> 14) : ((row - NPROMPT) >> 5), s = isp ? (row & (SEQ - 1)) : ((row - NPROMPT) & 31);
                    if (reg < 4) { *(u32x4*)(Q0 + (size_t)row * 1024 + cbase + cw) = w; }
                    else if (reg < 12) {
                        const bool isk = reg < 8; const int c = cbase - (isk ? 512 : 1024) + cw;
                        const int kr = isp ? row : NPROMPT + b * (LA + 32) + LA + s;
                        *(u32x4*)((isk ? KA : VA) + (size_t)kr * 512 + c) = w;
                        float* o = nullptr;
                        if (isp) { if (s >= SEQ - LA) o = out + (isk ? O_AKP : O_AVP) + (size_t)(b * LA + s - (SEQ - LA)) * 512 + c; }
                        else o = out + (isk ? O_AKS : O_AVS) + (size_t)(row - NPROMPT) * 512 + c;
                        if (o) { *(f32x4*)o = v0; *(f32x4*)(o + 4) = v1; }
                    } else if (reg < 16) { *(u32x4*)(Q0 + (size_t)row * 1024 + 512 + (cbase - 1536) + cw) = w; }
                    else {
                        const bool isk = reg == 16; const int c = cw;
                        const int kr = isp ? row : NPROMPT + b * (LB + 32) + LB + s;
                        *(u32x4*)((isk ? KB : VB) + (size_t)kr * 128 + c) = w;
                        float* o = nullptr;
                        if (isp) { if (s >= SEQ - LB) o = out + (isk ? O_BKP : O_BVP) + (size_t)(b * LB + s - (SEQ - LB)) * 128 + c; }
                        else o = out + (isk ? O_BKS : O_BVS) + (size_t)(row - NPROMPT) * 128 + c;
                        if (o) { *(f32x4*)o = v0; *(f32x4*)(o + 4) = v1; }
                    }
                }
        }
    }
};
struct EpiF32 {
    static constexpr bool PERM = false, AFTER_DRAIN = false;
    float* C; int ldc;
    __device__ __forceinline__ void operator()(const f32x4 (&acc)[2][2][4][2], const Unit& u, int wr, int wc, int fr, int fq) const {
        { int l_; asm volatile("v_mbcnt_lo_u32_b32 %0, -1, 0\n\tv_mbcnt_hi_u32_b32 %0, -1, %0" : "=v"(l_)); fr = l_ & 15; fq = (l_ >> 4) & 3; }
        const int row0 = u.pm * BM + wr * 64 + fr, col0 = u.pn * BM + wc * 32 + 4 * fq;
#pragma unroll
        for (int ai = 0; ai < 2; ++ai)
#pragma unroll
            for (int m = 0; m < 4; ++m) { float* xp = C + (size_t)(row0 + ai * HALF + m * 16) * ldc;
#pragma unroll
                for (int bj = 0; bj < 2; ++bj)
#pragma unroll
                    for (int n = 0; n < 2; ++n) *(f32x4*)(xp + col0 + bj * HALF + n * 16) = acc[ai][bj][m][n]; }
    }
};
struct EpiBF {
    static constexpr bool PERM = true, AFTER_DRAIN = false;
    bf16_t* C; int ldc;
    __device__ __forceinline__ void operator()(const f32x4 (&acc)[2][2][4][2], const Unit& u, int wr, int wc, int fr, int fq) const {
        { int l_; asm volatile("v_mbcnt_lo_u32_b32 %0, -1, 0\n\tv_mbcnt_hi_u32_b32 %0, -1, %0" : "=v"(l_)); fr = l_ & 15; fq = (l_ >> 4) & 3; }
        const int row0 = u.pm * BM + wr * 64 + fr, col0 = u.pn * BM + wc * 32 + 8 * fq;
#pragma unroll
        for (int ai = 0; ai < 2; ++ai)
#pragma unroll
            for (int m = 0; m < 4; ++m) { bf16_t* xp = C + (size_t)(row0 + ai * HALF + m * 16) * ldc + col0;
#pragma unroll
                for (int bj = 0; bj < 2; ++bj) *(u32x4*)(xp + bj * HALF) = pack8(acc[ai][bj][m][0], acc[ai][bj][m][1]); }
    }
};
struct EpiKV {
    static constexpr bool PERM = true, AFTER_DRAIN = false;
    bf16_t *KC, *VC;
    __device__ __forceinline__ void operator()(const f32x4 (&acc)[2][2][4][2], const Unit& u, int wr, int wc, int fr, int fq) const {
        { int l_; asm volatile("v_mbcnt_lo_u32_b32 %0, -1, 0\n\tv_mbcnt_hi_u32_b32 %0, -1, %0" : "=v"(l_)); fr = l_ & 15; fq = (l_ >> 4) & 3; }
        const int row0 = u.pm * BM + wr * 64 + fr;
#pragma unroll
        for (int bj = 0; bj < 2; ++bj) {
            const int head = (u.pn * BM + bj * HALF) >> 7; bf16_t* dst = (wc < 2 ? KC : VC) + head * 64 + (wc & 1) * 32 + 8 * fq;
#pragma unroll
            for (int ai = 0; ai < 2; ++ai)
#pragma unroll
                for (int m = 0; m < 4; ++m) *(u32x4*)(dst + (size_t)(row0 + ai * HALF + m * 16) * 1024) = pack8(acc[ai][bj][m][0], acc[ai][bj][m][1]);
        }
    }
};
template <class Epi, class Sched, bool ALIGN_EPI = false, bool SP2 = false>
__device__ __forceinline__ void gemm_phase(PG8_LAS unsigned char* lds, const Gemm g, const Sched& S, const Epi& E, int wave_s_) {
    const int tid = tidx_from(wave_s_), wid = __builtin_amdgcn_readfirstlane(tid >> 6), lane = tid & 63, wr = wid >> 2, wc = wid & 3, fr = lane & 15, fq = lane >> 4;
    const int K = g.K;
    unsigned voffA[2], voffB[2];
#pragma unroll
    for (int i = 0; i < 2; ++i) { int R, C; stage_rc(tid * 16 + i * 8192, R, C); const int Rb = Epi::PERM ? ((R & ~31) + perm32(R & 31)) : R;
        voffA[i] = (unsigned)(R * K + C) * 2u; voffB[i] = (unsigned)(Rb * K + C) * 2u; }
    const size_t kstep = (size_t)(BK * 2);
    const size_t hstep = (size_t)HALF * K * 2;
    const size_t tstep = 2 * hstep;
    const unsigned ldsw = (unsigned)wid * 1024u;
    const int aoff = lds_byte(wr * 64 + fr, fq * 8), boff = lds_byte(wc * 32 + fr, fq * 8);
#define PG8_SA(b, h) (((b) * 2 + (h)) * HTB)
#define PG8_SB(b, h) ((4 + (b) * 2 + (h)) * HTB)
#define PG8_STAGE(bufoff, gbase, voff) do { _Pragma("unroll") for (int _i = 0; _i < 2; ++_i) \
        __builtin_amdgcn_global_load_lds((const unsigned*)((const char*)(gbase) + (voff)[_i]), (PG8_LAS unsigned*)(lds + (bufoff) + ldsw + _i * 8192), 16, 0, 0); } while (0)
#define PG8_LDA(dst, b, h) do { _Pragma("unroll") for (int m = 0; m < 4; ++m) _Pragma("unroll") for (int k = 0; k < 2; ++k) dst[m][k] = *(const PG8_LAS bf16x8*)(lds + PG8_SA(b, h) + aoff + m * 2048 + k * 1024); } while (0)
#define PG8_LDB(dst, b, h) do { _Pragma("unroll") for (int n = 0; n < 2; ++n) _Pragma("unroll") for (int k = 0; k < 2; ++k) dst[n][k] = *(const PG8_LAS bf16x8*)(lds + PG8_SB(b, h) + boff + n * 2048 + k * 1024); } while (0)
#define PG8_MMA(ai, bj, At, Bt) do { __builtin_amdgcn_s_setprio(1); _Pragma("unroll") for (int m = 0; m < 4; ++m) _Pragma("unroll") for (int n = 0; n < 2; ++n) _Pragma("unroll") for (int k = 0; k < 2; ++k) \
        acc[ai][bj][m][n] = __builtin_amdgcn_mfma_f32_16x16x32_bf16(Bt[n][k], At[m][k], acc[ai][bj][m][n], 0, 0, 0); __builtin_amdgcn_s_setprio(0); } while (0)
#define PG8_WAIT_V(n) asm volatile("s_waitcnt vmcnt(" #n ")" ::: "memory")
#define PG8_WAIT_L(n) asm volatile("s_waitcnt lgkmcnt(" #n ")" ::: "memory")
#define PG8_BAR __builtin_amdgcn_s_barrier()
#define PG8_SCHED __builtin_amdgcn_sched_barrier(0)
    Unit cur, nxt; int ui = 0;
    if (!S.next(0, cur)) return;
    f32x4 acc[2][2][4][2];
#pragma unroll
    for (int a = 0; a < 2; ++a)
#pragma unroll
        for (int b = 0; b < 2; ++b)
#pragma unroll
            for (int m = 0; m < 4; ++m)
#pragma unroll
                for (int n = 0; n < 2; ++n) acc[a][b][m][n] = (f32x4){0.f, 0.f, 0.f, 0.f};
    bf16x8 At[4][2], B0[2][2], B1[2][2];
    const char* cA = (const char*)g.A + (size_t)(cur.pm & 4095) * tstep + (size_t)S.k0_of(cur) * kstep; const char* cB = (const char*)g.Bt + (size_t)cur.pn * tstep + (size_t)S.k0_of(cur) * kstep;
    S.a_ready(cur);
    if constexpr (SP2) {
        PG8_STAGE(PG8_SB(0, 0), cB, voffB); PG8_STAGE(PG8_SB(0, 1), cB + hstep, voffB); PG8_STAGE(PG8_SA(0, 0), cA, voffA); PG8_STAGE(PG8_SA(0, 1), cA + hstep, voffA);
        if (wr == 1) PG8_BAR;
        PG8_WAIT_V(2); PG8_BAR;
        PG8_STAGE(PG8_SB(1, 0), cB + kstep, voffB); PG8_STAGE(PG8_SA(1, 0), cA + kstep, voffA); PG8_STAGE(PG8_SB(1, 1), cB + hstep + kstep, voffB);
        PG8_WAIT_V(6); PG8_BAR;
    } else {
        PG8_STAGE(PG8_SB(0, 0), cB, voffB); PG8_STAGE(PG8_SA(0, 0), cA, voffA); PG8_STAGE(PG8_SB(0, 1), cB + hstep, voffB); PG8_STAGE(PG8_SA(0, 1), cA + hstep, voffA);
        if (wr == 1) PG8_BAR;
        PG8_WAIT_V(4); PG8_BAR;
        PG8_STAGE(PG8_SB(1, 0), cB + kstep, voffB); PG8_STAGE(PG8_SA(1, 0), cA + kstep, voffA); PG8_STAGE(PG8_SB(1, 1), cB + hstep + kstep, voffB);
        PG8_WAIT_V(6); PG8_BAR;
    }
    for (;;) {
        const bool has_next = S.next(ui + 1, nxt);
        const char* nA = has_next ? (const char*)g.A + (size_t)(nxt.pm & 4095) * tstep + (size_t)S.k0_of(nxt) * kstep : cA; const char* nB = has_next ? (const char*)g.Bt + (size_t)nxt.pn * tstep + (size_t)S.k0_of(nxt) * kstep : cB;
        const int nt = S.nt_of(cur);
        for (int t = 0; t < nt; t += 2) {
            const bool last = (t == nt - 2);
            const char* a1 = cA + (size_t)(t + 1) * kstep;
            const char* a2 = last ? nA : cA + (size_t)(t + 2) * kstep; const char* b2 = last ? nB : cB + (size_t)(t + 2) * kstep;
            const char* a3 = a2 + kstep; const char* b3 = b2 + kstep;
            if (last && has_next) S.a_ready(nxt);
            if constexpr (SP2) {
            PG8_LDB(B0, 0, 0); PG8_LDB(B1, 0, 1); PG8_SCHED; PG8_LDA(At, 0, 0); PG8_STAGE(PG8_SA(1, 1), a1 + hstep, voffA);
            PG8_WAIT_V(8); PG8_WAIT_L(0); PG8_BAR; PG8_MMA(0, 0, At, B0); PG8_MMA(0, 1, At, B1); PG8_BAR; PG8_SCHED;
            PG8_LDA(At, 0, 1); PG8_STAGE(PG8_SB(0, 0), b2, voffB); PG8_STAGE(PG8_SB(0, 1), b2 + hstep, voffB); PG8_STAGE(PG8_SA(0, 0), a2, voffA);
            PG8_WAIT_V(8); PG8_WAIT_L(0); PG8_BAR; PG8_MMA(1, 0, At, B0); PG8_MMA(1, 1, At, B1); PG8_BAR; PG8_SCHED;
            PG8_LDB(B0, 1, 0); PG8_LDB(B1, 1, 1); PG8_SCHED; PG8_LDA(At, 1, 0); PG8_STAGE(PG8_SA(0, 1), a2 + hstep, voffA);
            PG8_WAIT_V(8); PG8_WAIT_L(0); PG8_BAR; PG8_MMA(0, 0, At, B0); PG8_MMA(0, 1, At, B1); PG8_BAR; PG8_SCHED;
            PG8_LDA(At, 1, 1); PG8_STAGE(PG8_SB(1, 0), b3, voffB); PG8_STAGE(PG8_SB(1, 1), b3 + hstep, voffB); PG8_STAGE(PG8_SA(1, 0), a3, voffA);
            PG8_WAIT_V(8); PG8_WAIT_L(0); PG8_BAR; PG8_MMA(1, 0, At, B0); PG8_MMA(1, 1, At, B1); PG8_BAR; PG8_SCHED;
            } else {
            PG8_LDB(B0, 0, 0); PG8_SCHED; PG8_LDA(At, 0, 0); PG8_STAGE(PG8_SA(1, 1), a1 + hstep, voffA);
            PG8_WAIT_L(8); PG8_BAR; PG8_WAIT_L(0); PG8_MMA(0, 0, At, B0); PG8_BAR; PG8_SCHED;
            PG8_LDB(B1, 0, 1); PG8_STAGE(PG8_SB(0, 0), b2, voffB);
            PG8_BAR; PG8_WAIT_L(0); PG8_MMA(0, 1, At, B1); PG8_BAR;
            PG8_LDA(At, 0, 1); PG8_STAGE(PG8_SA(0, 0), a2, voffA);
            PG8_BAR; PG8_WAIT_L(0); PG8_MMA(1, 0, At, B0); PG8_BAR; PG8_SCHED;
            PG8_STAGE(PG8_SB(0, 1), b2 + hstep, voffB);
            PG8_WAIT_V(6); PG8_BAR; PG8_MMA(1, 1, At, B1); PG8_BAR;
            PG8_LDB(B0, 1, 0); PG8_SCHED; PG8_LDA(At, 1, 0); PG8_STAGE(PG8_SA(0, 1), a2 + hstep, voffA);
            PG8_WAIT_L(8); PG8_BAR; PG8_WAIT_L(0); PG8_MMA(0, 0, At, B0); PG8_BAR; PG8_SCHED;
            PG8_LDB(B1, 1, 1); PG8_STAGE(PG8_SB(1, 0), b3, voffB);
            PG8_BAR; PG8_WAIT_L(0); PG8_MMA(0, 1, At, B1); PG8_BAR;
            PG8_LDA(At, 1, 1); PG8_STAGE(PG8_SA(1, 0), a3, voffA);
            PG8_BAR; PG8_WAIT_L(0); PG8_MMA(1, 0, At, B0); PG8_BAR; PG8_SCHED;
            PG8_STAGE(PG8_SB(1, 1), b3 + hstep, voffB);
            PG8_WAIT_V(6); PG8_BAR; PG8_MMA(1, 1, At, B1); PG8_BAR;
            }
        }
        if constexpr (ALIGN_EPI) { if (wr == 0) PG8_BAR; }
        if constexpr (!Epi::AFTER_DRAIN) { E(acc, cur, wr, wc, fr, fq); S.done(cur); }
        if (!has_next) break;
#pragma unroll
        for (int a = 0; a < 2; ++a)
#pragma unroll
            for (int b = 0; b < 2; ++b)
#pragma unroll
                for (int m = 0; m < 4; ++m)
#pragma unroll
                    for (int n = 0; n < 2; ++n) acc[a][b][m][n] = (f32x4){0.f, 0.f, 0.f, 0.f};
        cur = nxt; cA = nA; cB = nB; ++ui;
        if constexpr (ALIGN_EPI) { if (wr == 1) PG8_BAR; }
    }
    PG8_WAIT_V(0);
    if constexpr (!ALIGN_EPI) { if (wr == 0) PG8_BAR; }
    PG8_BAR;
    if constexpr (Epi::AFTER_DRAIN) { E.fused(acc, cur, wr, wc, fr, fq, lds, wid, lane); S.done(cur); }
#undef PG8_SA
#undef PG8_SB
#undef PG8_STAGE
#undef PG8_LDA
#undef PG8_LDB
#undef PG8_MMA
#undef PG8_WAIT_V
#undef PG8_WAIT_L
#undef PG8_BAR
#undef PG8_SCHED
}
}

#define LAS __attribute__((address_space(3)))
typedef unsigned short bf16;
typedef float f32x4 __attribute__((ext_vector_type(4)));
typedef float f32x2 __attribute__((ext_vector_type(2)));
typedef float f32x16 __attribute__((ext_vector_type(16)));
typedef short bf16x8 __attribute__((ext_vector_type(8)));
typedef short s16x4 __attribute__((ext_vector_type(4)));
typedef unsigned u32x4 __attribute__((ext_vector_type(4)));
typedef unsigned u32x2 __attribute__((ext_vector_type(2)));
constexpr int NT = 512, NWAVES = 8;
__device__ __forceinline__ int tidx_from(int wv) { int l; asm volatile("v_mbcnt_lo_u32_b32 %0, -1, 0\n\tv_mbcnt_hi_u32_b32 %0, -1, %0" : "=v"(l)); return (wv << 6) | l; }
#define TIDX() tidx_from(wave_s_)
__device__ __forceinline__ int BIDX() { int v = blockIdx.x; asm volatile("" : "+s"(v)); return v; }
__device__ __forceinline__ int GDIM() { int v = gridDim.x; asm volatile("" : "+s"(v)); return v; }
constexpr int LDS_BYTES = 147456;

struct Args { const float* in[28]; float* out; unsigned char* ws; };
typedef const __attribute__((address_space(4))) Args* ArgsP;
__device__ __forceinline__ ArgsP get_args() { ArgsP p = (ArgsP)__builtin_amdgcn_kernarg_segment_ptr(); asm volatile("" : "+s"(p)); return p; }

__device__ __forceinline__ unsigned f2bf(float f) { unsigned u = __builtin_bit_cast(unsigned, f); return (u + 0x7fffu + ((u >> 16) & 1u)) >> 16; }
__device__ __forceinline__ unsigned pk2(float lo, float hi) { return pg8::cvt_pk_bf16(lo, hi); }
typedef float f32x2_t __attribute__((ext_vector_type(2))); typedef __bf16 bf16x2_t __attribute__((ext_vector_type(2)));
__device__ __forceinline__ unsigned pk2c(float lo, float hi) { f32x2_t v = {lo, hi}; bf16x2_t b = __builtin_convertvector(v, bf16x2_t); return __builtin_bit_cast(unsigned, b); }
__device__ __forceinline__ float max3f(float a, float b, float c) { float r; asm("v_max3_f32 %0, %1, %2, %3" : "=v"(r) : "v"(a), "v"(b), "v"(c)); return r; }
__device__ __forceinline__ float shx(float v, int lane, int o) { return __builtin_bit_cast(float, __builtin_amdgcn_ds_bpermute((lane ^ o) << 2, __builtin_bit_cast(int, v))); }
__device__ __forceinline__ float dpp_add(float v, float src_, const int ctrl, const int row_mask) { return v; }
__device__ __forceinline__ float wave_sum(float v, int lane) {
    (void)lane;
#define WS_DPP(ctrl_, rmask_) v += __builtin_bit_cast(float, __builtin_amdgcn_update_dpp(0, __builtin_bit_cast(int, v), ctrl_, rmask_, 0xF, false))
    WS_DPP(0xB1, 0xF);
    WS_DPP(0x4E, 0xF);
    WS_DPP(0x141, 0xF);
    WS_DPP(0x140, 0xF);
    WS_DPP(0x142, 0xA);
    WS_DPP(0x143, 0xC);
#undef WS_DPP
    return __builtin_bit_cast(float, __builtin_amdgcn_readlane(__builtin_bit_cast(int, v), 63));
}

__device__ __forceinline__ void transpose_item(const float* W, int K, int N, bf16* WT, int k0, int n0, int drow0, LAS float* scr, int lane) {
    float wv[32];
#pragma unroll
    for (int i = 0; i < 32; ++i) wv[i] = W[(size_t)(k0 + 2 * i + (lane >> 5)) * N + n0 + (lane & 31)];
#pragma unroll
    for (int i = 0; i < 32; ++i) scr[(2 * i + (lane >> 5)) * 33 + (lane & 31)] = wv[i];
    asm volatile("s_waitcnt lgkmcnt(0)" ::: "memory");
    const int c = lane & 7;
#pragma unroll
    for (int j = 0; j < 4; ++j) { const int n = (lane >> 3) + 8 * j; const LAS float* s = scr + (8 * c) * 33 + n;
        u32x4 o; o.x = pk2(s[0 * 33], s[1 * 33]); o.y = pk2(s[2 * 33], s[3 * 33]); o.z = pk2(s[4 * 33], s[5 * 33]); o.w = pk2(s[6 * 33], s[7 * 33]);
        *(u32x4*)(WT + (size_t)(drow0 + n) * K + k0 + 8 * c) = o; }
    asm volatile("s_waitcnt lgkmcnt(0)" ::: "memory");
}

__device__ __forceinline__ bool transpose_job(int& it, const float* W, int K, int N, bf16* WT, int mode, LAS float* scr, int lane) {
    const int nblk = N / 32, items = (K / 64) * nblk;
    if (it >= items) { it -= items; return false; }
    const int kb = it / nblk, nb = it % nblk, n0 = 32 * nb;
    const int drow0 = mode == 0 ? n0 : (256 * (n0 >> 7) + (n0 & 127) + (mode == 2 ? 128 : 0));
    transpose_item(W, K, N, WT, 64 * kb, n0, drow0, scr, lane);
    return true;
}

__device__ __forceinline__ void cvt_rows(const float* src, bf16* dst, int nb, int L, int W, int base, int Lp, int gtid, int gthreads) {
    const int w4 = W / 4, total = nb * L * w4;
    for (int i = gtid; i < total; i += gthreads) {
        const int c4 = i % w4, rj = i / w4, j = rj % L, b = rj / L;
        const f32x4 v = *(const f32x4*)(src + (size_t)i * 4);
        u32x2 o; o.x = pk2(v[0], v[1]); o.y = pk2(v[2], v[3]);
        *(u32x2*)(dst + (size_t)(base + b * Lp + j) * W + c4 * 4) = o;
    }
}

__device__ __forceinline__ void zero16(void* p_, int n16, int gtid, int gthreads) { unsigned z = 0u; asm volatile("" : "+v"(z)); for (int i = gtid; i < n16; i += gthreads) ((u32x4*)p_)[i] = (u32x4){z, z, z, z}; }
__device__ __forceinline__ int t5_bucket(int rel) {
    const int ret = rel > 0 ? 16 : 0; const int n = rel < 0 ? -rel : rel;
    if (n < 8) return ret + n;
    int j = 0; const long long n2 = (long long)n * n;
    while (j < 20 && (64ll << (j + 1)) <= n2) ++j;
    int large = 8 + j; if (large > 15) large = 15;
    return ret + large;
}

__device__ __forceinline__ void prologue(ArgsP a, LAS unsigned char* lds, int wave_s_) {
    const int tid = TIDX(), lane = tid & 63, wave = tid >> 6;
    unsigned char* ws = a->ws;
    const int G = GDIM(), gw = BIDX() * NWAVES + wave, NGW = G * NWAVES, gtid = BIDX() * NT + tid, gthreads = G * NT;
    {
        LAS float* sc = (LAS float*)lds;
        LAS float* red = (LAS float*)(lds + NSEQ * 1024 * 4);
        for (int i = tid; i < NSEQ * 1024; i += NT) { const int ci = i >> 10, k = i & 1023; const float c = ci < 2 ? a->in[2][ci * 1024 + k] : a->in[3][(ci - 2) * 1024 + k]; sc[i] = c / (1.0f + __expf(-c)); }
        __syncthreads();
        float* MODS = (float*)(ws + WS_MODS);
        const int col = tid & 63, kg = tid >> 6;
        for (int item = BIDX(); item < 2 * (NMOD / 64); item += G) {
            const int l = item / (NMOD / 64), n = (item % (NMOD / 64)) * 64 + col;
            const float* wp = a->in[10] + (size_t)l * 1024 * NMOD + (size_t)(kg * 128) * NMOD + n;
            float acc[NSEQ];
#pragma unroll
            for (int ci = 0; ci < NSEQ; ++ci) acc[ci] = 0.f;
            for (int k8 = 0; k8 < 128; k8 += 16) { float w[16];
#pragma unroll
                for (int u = 0; u < 16; ++u) w[u] = wp[(size_t)(k8 + u) * NMOD];
#pragma unroll
                for (int u = 0; u < 16; ++u)
#pragma unroll
                    for (int ci = 0; ci < NSEQ; ++ci) acc[ci] += sc[ci * 1024 + kg * 128 + k8 + u] * w[u]; }
#pragma unroll
            for (int ci = 0; ci < NSEQ; ++ci) red[(kg * NSEQ + ci) * 64 + col] = acc[ci];
            __syncthreads();
            for (int i = tid; i < NSEQ * 64; i += NT) { const int ci = i >> 6, cc = i & 63; float s = 0.f;
#pragma unroll
                for (int g = 0; g < 8; ++g) s += red[(g * NSEQ + ci) * 64 + cc];
                const int nn = (item % (NMOD / 64)) * 64 + cc; MODS[((size_t)l * NSEQ + ci) * NMOD + nn] = s + a->in[11][l * NMOD + nn]; }
            __syncthreads();
        }
    }
    __syncthreads();
    {
        LAS float* scr = (LAS float*)(lds + wave * 16384);
        constexpr int I_GU = (1024 / 64) * (DFF / 32), I_D = (DFF / 64) * (1024 / 32);
        constexpr int NITEMS = 8 * I_GU + 4 * I_D + 16 * 72 + 16 * 32 + 16 * 21 + 6 * 48 + 4 * 64 + 16 * 32;
        for (int it0 = gw; it0 < NITEMS; it0 += NGW) {
            int it = it0; bool done = false;
            for (int lj = 0; lj < 4 && !done; ++lj) {
                done = transpose_job(it, a->in[14] + (size_t)lj * 1024 * DFF, 1024, DFF, (bf16*)(ws + WS_WGU + lj * SZ_WGU), 1, scr, lane);
                if (!done) done = transpose_job(it, a->in[15] + (size_t)lj * 1024 * DFF, 1024, DFF, (bf16*)(ws + WS_WGU + lj * SZ_WGU), 2, scr, lane);
                if (!done) done = transpose_job(it, a->in[16] + (size_t)lj * DFF * 1024, DFF, 1024, (bf16*)(ws + WS_WD + lj * SZ_WD), 0, scr, lane);
            }
            if (!done) done = transpose_job(it, a->in[17], 1024, 2304, (bf16*)(ws + WS_WAB), 0, scr, lane);
            if (!done) done = transpose_job(it, a->in[18], 1024, 1024, (bf16*)(ws + WS_WOAB), 0, scr, lane);
            if (!done) done = transpose_job(it, a->in[22], 1024, 672, (bf16*)(ws + WS_WCIN), 0, scr, lane);
            if (!done) done = transpose_job(it, a->in[25], 384, 1536, (bf16*)(ws + WS_WQB), 0, scr, lane);
            if (!done) done = transpose_job(it, a->in[26], 256, 2048, (bf16*)(ws + WS_WKVB), 0, scr, lane);
            if (!done) done = transpose_job(it, a->in[27], 1024, 1024, (bf16*)(ws + WS_WOC), 0, scr, lane);
        }
        zero16(ws + WS_WCIN + (size_t)672 * 1024 * 2, 96 * 1024 * 2 / 16, gtid, gthreads);
    }
    {
        float* rope = (float*)(ws + WS_ROPE);
        for (int i = gtid; i < SEQ * 16; i += gthreads) { const int pos = i >> 4, k = i & 15;
            const float inv = (float)pow(10000.0, -(double)k / 16.0); const float ang = (float)pos * inv;
            rope[pos * 32 + k] = (float)cos((double)ang); rope[pos * 32 + 16 + k] = (float)sin((double)ang); }
        float* lutA = (float*)(ws + WS_LUTA); float* lutB = (float*)(ws + WS_LUTB);
        for (int i = gtid; i < 8 * LUTN; i += gthreads) { const int h = i / LUTN, rel = (i % LUTN) - LUT0;
            const int cl = rel < -128 ? -128 : (rel > 128 ? 128 : rel);
            lutA[i] = a->in[19][(cl + 128) * 8 + h] * LOG2E;
            lutB[i] = a->in[20][t5_bucket(rel) * 8 + h] * LOG2E; }
    }
}
__device__ __forceinline__ void prologue_l1(ArgsP a, int wave_s_) {
    const int gtid = BIDX() * NT + TIDX(), gthreads = GDIM() * NT;
    cvt_rows(a->in[8], (bf16*)(a->ws + WS_KVN), 16, PAST, 256, NPROMPT, PAST + 32, gtid, gthreads);
    cvt_rows(a->in[9], (bf16*)(a->ws + WS_KR), 16, PAST, 32, NPROMPT, PAST + 32, gtid, gthreads);
    zero16(a->ws + WS_KR + (size_t)RKV * 32 * 2, 64 * 32 * 2 / 16, gtid, gthreads);
}

__device__ __forceinline__ void norm_mod_phase(ArgsP a, bool from_input, const float* g, const float* modsL, int ishift, int iscale, int nparts, int wave_s_) {
    const int lane = TIDX() & 63, gw = BIDX() * NWAVES + (TIDX() >> 6), NGW = GDIM() * NWAVES;
    float* X = a->out; bf16* H = (bf16*)(a->ws + WS_H);
    const float* xin0 = a->in[0]; const float* xin1 = a->in[1];
    f32x4 gv[4];
#pragma unroll
    for (int j = 0; j < 4; ++j) gv[j] = *(const f32x4*)(g + 4 * lane + 256 * j);
#define NM_ROWPTR(r_) ((from_input ? ((r_) < NPROMPT ? xin0 + (size_t)(r_) * DM : xin1 + (size_t)((r_) - NPROMPT) * DM) : X + (size_t)(r_) * DM) + 4 * lane)
    f32x4 v[4];
    if (gw < R) { const float* xr = NM_ROWPTR(gw);
#pragma unroll
        for (int j = 0; j < 4; ++j) v[j] = *(const f32x4*)(xr + 256 * j); }
    for (int row = gw; row < R; row += NGW) {
        const int nrow = row + NGW; f32x4 vn[4];
        if (nrow < R) { const float* xr = NM_ROWPTR(nrow);
#pragma unroll
            for (int j = 0; j < 4; ++j) vn[j] = *(const f32x4*)(xr + 256 * j); }
        if (row >= NPROMPT && nparts > 0) {
            int l2 = lane; asm volatile("" : "+v"(l2));
            const float* pp = (const float*)(a->ws + WS_PART) + (size_t)(row - NPROMPT) * DM + 4 * l2;
            for (int s = 0; s < nparts; ++s)
#pragma unroll
                for (int j = 0; j < 4; ++j) v[j] = v[j] + *(const f32x4*)(pp + (size_t)s * NSAMP * DM + 256 * j);
        }
        float ss = 0.f;
#pragma unroll
        for (int j = 0; j < 4; ++j) ss += (v[j][0] * v[j][0] + v[j][1] * v[j][1]) + (v[j][2] * v[j][2] + v[j][3] * v[j][3]);
        if ((from_input && row >= NPROMPT) || (row >= NPROMPT && nparts > 0)) {
#pragma unroll
            for (int j = 0; j < 4; ++j) *(f32x4*)(X + (size_t)row * DM + 4 * lane + 256 * j) = v[j];
        }
        f32x4 shv[4], scv[4];
        {   const float* mp = modsL + (size_t)pg8::cidx_of(row) * NMOD + 4 * lane;
#pragma unroll
            for (int j = 0; j < 4; ++j) { shv[j] = *(const f32x4*)(mp + ishift * DM + 256 * j); scv[j] = *(const f32x4*)(mp + iscale * DM + 256 * j); } }
        const float rs = 1.0f / sqrtf(wave_sum(ss, lane) * (1.0f / DM) + EPS);
#pragma unroll
        for (int j = 0; j < 4; ++j) { const f32x4 sh = shv[j], sc = scv[j];
            const f32x4 h = (v[j] * rs) * gv[j] * (sc + 1.0f) + sh;
            u32x2 o; o.x = pk2(h[0], h[1]); o.y = pk2(h[2], h[3]);
            *(u32x2*)(H + (size_t)row * DM + 4 * lane + 256 * j) = o; }
#pragma unroll
        for (int j = 0; j < 4; ++j) v[j] = vn[j];
    }
#undef NM_ROWPTR
}
__device__ __forceinline__ void final_norm_phase(ArgsP a, int wave_s_) {
    const int lane = TIDX() & 63, gw = BIDX() * NWAVES + (TIDX() >> 6), NGW = GDIM() * NWAVES;
    const float* g = a->in[13]; f32x4 gv[4];
#pragma unroll
    for (int j = 0; j < 4; ++j) gv[j] = *(const f32x4*)(g + 4 * lane + 256 * j);
    f32x4 v[4];
    if (gw < R) {
#pragma unroll
        for (int j = 0; j < 4; ++j) v[j] = *(const f32x4*)(a->out + (size_t)gw * DM + 4 * lane + 256 * j); }
    for (int row = gw; row < R; row += NGW) {
        float* xr = a->out + (size_t)row * DM; const int nrow = row + NGW; f32x4 vn[4];
        if (nrow < R) {
#pragma unroll
            for (int j = 0; j < 4; ++j) vn[j] = *(const f32x4*)(a->out + (size_t)nrow * DM + 4 * lane + 256 * j); }
        if (row >= NPROMPT) { int l2 = lane; asm volatile("" : "+v"(l2)); const float* pp = (const float*)(a->ws + WS_PART) + (size_t)(row - NPROMPT) * DM + 4 * l2;
            for (int s = 0; s < 11; ++s)
#pragma unroll
                for (int j = 0; j < 4; ++j) v[j] = v[j] + *(const f32x4*)(pp + (size_t)s * NSAMP * DM + 256 * j); }
        float ss = 0.f;
#pragma unroll
        for (int j = 0; j < 4; ++j) ss += (v[j][0] * v[j][0] + v[j][1] * v[j][1]) + (v[j][2] * v[j][2] + v[j][3] * v[j][3]);
        const float rs = 1.0f / sqrtf(wave_sum(ss, lane) * (1.0f / DM) + EPS);
#pragma unroll
        for (int j = 0; j < 4; ++j) *(f32x4*)(xr + 4 * lane + 256 * j) = (v[j] * rs) * gv[j];
#pragma unroll
        for (int j = 0; j < 4; ++j) v[j] = vn[j];
    }
}
__device__ __forceinline__ void mla_norm_phase(ArgsP a, int wave_s_) {
    const int lane = TIDX() & 63, gw = BIDX() * NWAVES + (TIDX() >> 6), NGW = GDIM() * NWAVES;
    const float* CIN = (const float*)(a->ws + WS_CIN); const float* rope = (const float*)(a->ws + WS_ROPE);
    bf16* QN = (bf16*)(a->ws + WS_QN); bf16* KVN = (bf16*)(a->ws + WS_KVN); bf16* KR = (bf16*)(a->ws + WS_KR);
    const float* qg = a->in[23]; const float* kg = a->in[24];
    f32x2 qgv[3];
#pragma unroll
    for (int j = 0; j < 3; ++j) qgv[j] = *(const f32x2*)(qg + 2 * lane + 128 * j);
    const f32x4 kgv = *(const f32x4*)(kg + 4 * lane);
    f32x2 q[3]; f32x4 kv; float kr1 = 0.f, kr2 = 0.f;
#define MN_LOAD(qd_, kvd_, k1_, k2_, r_) do { if ((r_) < R) { const float* c_ = CIN + (size_t)(r_) * 768; _Pragma("unroll") for (int j = 0; j < 3; ++j) qd_[j] = *(const f32x2*)(c_ + 2 * lane + 128 * j); \
        kvd_ = *(const f32x4*)(c_ + 384 + 4 * lane); if (lane < 16) { k1_ = c_[640 + lane]; k2_ = c_[656 + lane]; } } } while (0)
    MN_LOAD(q, kv, kr1, kr2, gw);
    for (int row = gw; row < R; row += NGW) {
        f32x2 qn[3]; f32x4 kvn; float kn1 = 0.f, kn2 = 0.f;
        MN_LOAD(qn, kvn, kn1, kn2, row + NGW);
        const bool isp = row < NPROMPT; const int rs = row - NPROMPT, b = rs >> 5, t = rs & 31;
        const int kvrow = isp ? row : NPROMPT + b * (PAST + 32) + PAST + t; const int pos = isp ? (row & (SEQ - 1)) : PAST + t;
        float cs_ = 0.f, sn_ = 0.f; if (lane < 16) { cs_ = rope[(size_t)pos * 32 + lane]; sn_ = rope[(size_t)pos * 32 + 16 + lane]; }
        float ss = 0.f;
#pragma unroll
        for (int j = 0; j < 3; ++j) ss += q[j][0] * q[j][0] + q[j][1] * q[j][1];
        float s2 = (kv[0] * kv[0] + kv[1] * kv[1]) + (kv[2] * kv[2] + kv[3] * kv[3]);
        const float rq = 1.0f / sqrtf(wave_sum(ss, lane) * (1.0f / 384.0f) + EPS), rk = 1.0f / sqrtf(wave_sum(s2, lane) * (1.0f / 256.0f) + EPS);
#pragma unroll
        for (int j = 0; j < 3; ++j) { const f32x2 o = (q[j] * rq) * qgv[j]; *(unsigned*)(QN + (size_t)row * 384 + 2 * lane + 128 * j) = pk2(o[0], o[1]); }
        const f32x4 ko = (kv * rk) * kgv;
        float* okv = a->out + (isp ? O_CKVP + (size_t)row * 256 : O_CKVS + (size_t)rs * 256) + 4 * lane; *(f32x4*)okv = ko;
        u32x2 kw; kw.x = pk2(ko[0], ko[1]); kw.y = pk2(ko[2], ko[3]); *(u32x2*)(KVN + (size_t)kvrow * 256 + 4 * lane) = kw;
        if (lane < 16) {
            const float x1 = kr1, x2 = kr2, cs = cs_, sn = sn_;
            const float o1 = x1 * cs - x2 * sn, o2 = x1 * sn + x2 * cs;
            float* okr = a->out + (isp ? O_CKRP + (size_t)row * 32 : O_CKRS + (size_t)rs * 32);
            okr[lane] = o1; okr[16 + lane] = o2;
            KR[(size_t)kvrow * 32 + lane] = (bf16)f2bf(o1); KR[(size_t)kvrow * 32 + 16 + lane] = (bf16)f2bf(o2);
        }
#pragma unroll
        for (int j = 0; j < 3; ++j) q[j] = qn[j];
        kv = kvn; kr1 = kn1; kr2 = kn2;
    }
#undef MN_LOAD
}

struct AttnItem {
    const bf16* Q; int q_stride;
    const bf16* K; int k_stride;
    const bf16* K2;
    const float* rope;
    const bf16* V; int v_stride;
    bf16* O;
    int q_row0, nq_valid, k_row0, q_kidx0;
    int t_lo, t_hi, wlo0, whi0, wstep_lo, wstep, nkeys;
    const float* lut;
    float m0, l0, scale2;
};
constexpr int KSTR = 104, VROW = 72;
constexpr int KBUF = 64 * KSTR * 2, VBUF = 64 * VROW * 2;
constexpr int ATT_LUT_OFF = 2 * (KBUF + VBUF);
typedef short v4i16_t __attribute__((ext_vector_type(4)));
__device__ __forceinline__ int crow(int i, int hi) { return (i & 3) + 8 * (i >> 2) + 4 * hi; }
__device__ __forceinline__ s16x4 vtr(const LAS unsigned char* p) { return __builtin_bit_cast(s16x4, __builtin_amdgcn_ds_read_tr16_b64_v4i16((LAS v4i16_t*)p)); }
__device__ __forceinline__ float xhalf(float v, int hi) { auto r = __builtin_amdgcn_permlane32_swap(__builtin_bit_cast(unsigned, v), __builtin_bit_cast(unsigned, v), false, false); return __builtin_bit_cast(float, hi ? r[0] : r[1]); }
__device__ __forceinline__ float swapmax(float v, int hi) { return fmaxf(v, xhalf(v, hi)); }
__device__ __forceinline__ float swapsum(float v, int hi) { return v + xhalf(v, hi); }
__device__ __forceinline__ float bf2f(short b) { return __builtin_bit_cast(float, (unsigned)(unsigned short)b << 16); }
#define MFMA32(a, b, c) __builtin_amdgcn_mfma_f32_32x32x16_bf16((a), (b), (c), 0, 0, 0)
constexpr float RESCALE_THR = 8.0f;

template <int DQ, bool BIAS, bool TAIL>
__device__ __forceinline__ void attn_item(const AttnItem& A, LAS unsigned char* lds, int wave_s_) {
    constexpr int NKK = DQ / 16;
    const int tid = TIDX(), lane = tid & 63, w = __builtin_amdgcn_readfirstlane(tid >> 6), r32 = lane & 31, hi = lane >> 5;
    LAS float* lut = (LAS float*)(lds + ATT_LUT_OFF);
    __syncthreads();
    if (BIAS) { for (int i = tid; i < LUTN; i += NT) lut[i] = A.lut[i]; }
    const int wlo = max(A.wlo0 + w * A.wstep_lo, A.t_lo), whi = min(A.whi0 + w * A.wstep, A.t_hi);
    const int qrow = A.q_row0 + 64 * w;
    bf16x8 qf[2][NKK];
#pragma unroll
    for (int qb = 0; qb < 2; ++qb) {
        const int row = (wlo <= whi ? qrow : A.q_row0) + 32 * qb + r32;
        float qv[NKK][8];
#pragma unroll
        for (int kk = 0; kk < NKK; ++kk) { const bf16x8 raw = *(const bf16x8*)(A.Q + (size_t)row * A.q_stride + 16 * kk + 8 * hi);
#pragma unroll
            for (int j = 0; j < 8; ++j) qv[kk][j] = bf2f(raw[j]); }
        if (DQ == 96) {
            const int pos = row < NPROMPT ? (row & (SEQ - 1)) : PAST + ((row - NPROMPT) & 31);
            const float* rp = A.rope + (size_t)pos * 32 + 8 * hi;
            const f32x4 c0 = *(const f32x4*)rp, c1 = *(const f32x4*)(rp + 4), s0 = *(const f32x4*)(rp + 16), s1 = *(const f32x4*)(rp + 20);
#pragma unroll
            for (int j = 0; j < 8; ++j) { const float x1 = qv[NKK - 2][j], x2 = qv[NKK - 1][j], c = j < 4 ? c0[j & 3] : c1[j & 3], s = j < 4 ? s0[j & 3] : s1[j & 3];
                qv[NKK - 2][j] = x1 * c - x2 * s; qv[NKK - 1][j] = x1 * s + x2 * c; }
        }
#pragma unroll
        for (int kk = 0; kk < NKK; ++kk) { u32x4 wq;
#pragma unroll
            for (int jp = 0; jp < 4; ++jp) wq[jp] = pk2(qv[kk][2 * jp] * A.scale2, qv[kk][2 * jp + 1] * A.scale2);
            qf[qb][kk] = __builtin_bit_cast(bf16x8, wq); }
    }
    f32x16 o[2][2];
    float zinit = 0.f; asm volatile("" : "+v"(zinit));
    const f32x16 zero16v = {0.f, 0.f, 0.f, 0.f, 0.f, 0.f, 0.f, 0.f, 0.f, 0.f, 0.f, 0.f, 0.f, 0.f, 0.f, 0.f};
    float mref[2] = {A.m0, A.m0};
#pragma unroll
    for (int qb = 0; qb < 2; ++qb)
#pragma unroll
        for (int i = 0; i < 16; ++i) { o[0][qb][i] = zinit; o[1][qb][i] = zinit; }
    float lrun[2] = {hi == 0 ? A.l0 : 0.f, hi == 0 ? A.l0 : 0.f};
    bool first = A.l0 == 0.f;
    const int lkey = tid >> 3, lpc = tid & 7, l2key = tid >> 2, l2pc = tid & 3;
    u32x4 kreg, k2reg, vreg;
#define ATT_GLOAD(t_) do { const size_t row_ = (size_t)(A.k_row0 + 64 * (t_)); \
        kreg = *(const u32x4*)(A.K + (row_ + lkey) * A.k_stride + 8 * lpc); vreg = *(const u32x4*)(A.V + (row_ + lkey) * A.v_stride + 8 * lpc); \
        if (DQ == 96 && tid < 256) k2reg = *(const u32x4*)(A.K2 + (row_ + l2key) * 32 + 8 * l2pc); } while (0)
#define ATT_LSTORE(buf_) do { LAS unsigned char* kb_ = lds + (buf_) * KBUF; LAS unsigned char* vb_ = lds + 2 * KBUF + (buf_) * VBUF; \
        *(LAS u32x4*)(kb_ + (lkey * KSTR + 8 * lpc) * 2) = kreg; *(LAS u32x4*)(vb_ + (lkey * VROW + 8 * lpc) * 2) = vreg; \
        if (DQ == 96 && tid < 256) *(LAS u32x4*)(kb_ + (l2key * KSTR + 64 + 8 * l2pc) * 2) = k2reg; } while (0)
    ATT_GLOAD(A.t_lo); ATT_LSTORE(0);
    __syncthreads();
    const int i16 = lane & 15, vlane_off = ((4 * hi + (i16 >> 2)) * VROW + 16 * ((lane >> 4) & 1) + 4 * (i16 & 3)) * 2;
    const int koff = (r32 * KSTR + 8 * hi) * 2;
    if (w < 4) __builtin_amdgcn_s_setprio(2);
    int buf = 0;
    for (int t = A.t_lo; t <= A.t_hi; ++t) {
        const bool more = t < A.t_hi;
        const bool act = t >= wlo && t <= whi;
        const LAS unsigned char* kb = lds + buf * KBUF + koff; const LAS unsigned char* vb = lds + 2 * KBUF + buf * VBUF + vlane_off;
        bf16x8 kf[NKK];
        if (act) {
#pragma unroll
            for (int kk = 0; kk < NKK; ++kk) kf[kk] = *(const LAS bf16x8*)(kb + (16 * kk) * 2);
        }
        if (more) ATT_GLOAD(t + 1);
        if (act) {
#pragma unroll
            for (int kbk = 0; kbk < 2; ++kbk) {
                __builtin_amdgcn_sched_barrier(0);
                f32x16 s[2];
                s[0] = MFMA32(kf[0], qf[0][0], zero16v); s[1] = MFMA32(kf[0], qf[1][0], zero16v);
#pragma unroll
                for (int kk = 1; kk < NKK; ++kk) { s[0] = MFMA32(kf[kk], qf[0][kk], s[0]); s[1] = MFMA32(kf[kk], qf[1][kk], s[1]); }
                s16x4 vlo[2][2], vhi[2][2];
#pragma unroll
                for (int st = 0; st < 2; ++st)
#pragma unroll
                    for (int d = 0; d < 2; ++d) { const LAS unsigned char* vp = vb + ((32 * kbk + 16 * st) * VROW + 32 * d) * 2; vlo[st][d] = vtr(vp); vhi[st][d] = vtr(vp + 8 * VROW * 2); }
                __builtin_amdgcn_sched_barrier(0);
                float mx[2];
#pragma unroll
                for (int qb = 0; qb < 2; ++qb) {
                    if (BIAS || TAIL) {
                        const int qk = A.q_kidx0 + 64 * w + 32 * qb + r32;
#pragma unroll
                        for (int i = 0; i < 16; ++i) { const int kidx = 64 * t + 32 * kbk + crow(i, hi);
                            float v = s[qb][i]; if (BIAS) v += lut[kidx - qk + LUT0]; if (TAIL && kidx >= A.nkeys) v = -1.0e30f; s[qb][i] = v; }
                    }
                    const float t0 = max3f(s[qb][0], s[qb][1], s[qb][2]), t1 = max3f(s[qb][3], s[qb][4], s[qb][5]), t2 = max3f(s[qb][6], s[qb][7], s[qb][8]),
                                t3 = max3f(s[qb][9], s[qb][10], s[qb][11]), t4 = max3f(s[qb][12], s[qb][13], s[qb][14]);
                    const float m = max3f(max3f(t0, t1, t2), max3f(t3, t4, s[qb][15]), t0);
                    mx[qb] = swapmax(m, hi) - mref[qb];
                }
                const bool need0 = first || mx[0] > RESCALE_THR, need1 = first || mx[1] > RESCALE_THR;
                if (__builtin_amdgcn_ballot_w64(need0 || need1) != 0ull) {
#pragma unroll
                    for (int qb = 0; qb < 2; ++qb) {
                        const float delta = (qb == 0 ? need0 : need1) ? mx[qb] : 0.f, alpha = __builtin_amdgcn_exp2f(-delta);
#pragma unroll
                        for (int i = 0; i < 16; ++i) { o[0][qb][i] *= alpha; o[1][qb][i] *= alpha; }
                        lrun[qb] *= alpha; mref[qb] += delta;
                    }
                    first = false;
                }
#pragma unroll
                for (int qb = 0; qb < 2; ++qb) { float l4[4] = {0.f, 0.f, 0.f, 0.f};
#pragma unroll
                    for (int i = 0; i < 16; ++i) { const float pv = __builtin_amdgcn_exp2f(s[qb][i] - mref[qb]); s[qb][i] = pv; l4[i & 3] += pv; }
                    lrun[qb] += (l4[0] + l4[1]) + (l4[2] + l4[3]); }
                bf16x8 pf[2][2];
#pragma unroll
                for (int st = 0; st < 2; ++st)
#pragma unroll
                    for (int qb = 0; qb < 2; ++qb) { u32x4 pw;
#pragma unroll
                        for (int j = 0; j < 4; ++j) pw[j] = pk2c(s[qb][8 * st + 2 * j], s[qb][8 * st + 2 * j + 1]);
                        pf[st][qb] = __builtin_bit_cast(bf16x8, pw); }
                if (kbk == 0) {
#pragma unroll
                    for (int kk = 0; kk < NKK; ++kk) kf[kk] = *(const LAS bf16x8*)(kb + (32 * KSTR + 16 * kk) * 2);
                }
                __builtin_amdgcn_sched_barrier(0);
#pragma unroll
                for (int st = 0; st < 2; ++st)
#pragma unroll
                    for (int d = 0; d < 2; ++d) {
                        const bf16x8 vf = __builtin_shufflevector(vlo[st][d], vhi[st][d], 0, 1, 2, 3, 4, 5, 6, 7);
                        o[d][0] = MFMA32(vf, pf[st][0], o[d][0]);
                        o[d][1] = MFMA32(vf, pf[st][1], o[d][1]);
                    }
            }
        }
        if (more) ATT_LSTORE(buf ^ 1);
        __syncthreads();
        buf ^= 1;
    }
#undef ATT_GLOAD
#undef ATT_LSTORE
    __builtin_amdgcn_s_setprio(0);
    if (wlo <= whi) {
#pragma unroll
        for (int qb = 0; qb < 2; ++qb) {
            const float inv = 1.0f / swapsum(lrun[qb], hi);
            const int qi = 32 * qb + r32;
            if (qi < A.nq_valid) {
                bf16* op = A.O + (size_t)(qrow + qi) * 1024;
#pragma unroll
                for (int d = 0; d < 2; ++d)
#pragma unroll
                    for (int g = 0; g < 4; ++g) { u32x2 wv; wv.x = pk2(o[d][qb][4 * g] * inv, o[d][qb][4 * g + 1] * inv); wv.y = pk2(o[d][qb][4 * g + 2] * inv, o[d][qb][4 * g + 3] * inv);
                        *(u32x2*)(op + 32 * d + 8 * g + 4 * hi) = wv; }
            }
        }
    }
}

constexpr int OKSTR = 104, OVSTR = 68;
constexpr int OKBUF = 64 * OKSTR * 2, OVBUF = 64 * OVSTR * 2;
constexpr int OATT_LUT_OFF = 2 * (OKBUF + OVBUF);

template <int DQ, bool BIAS>
__device__ __forceinline__ void attn_item_l0(const AttnItem& A, LAS unsigned char* lds, int wave_s_) {
    constexpr int NKK = DQ / 16;
    const int tid = TIDX(), lane = tid & 63, w = __builtin_amdgcn_readfirstlane(tid >> 6), r32 = lane & 31, hi = lane >> 5;
    LAS float* lut = (LAS float*)(lds + OATT_LUT_OFF);
    __syncthreads();
    if (BIAS) { for (int i = tid; i < LUTN; i += NT) lut[i] = A.lut[i]; }
    const int wlo = max(A.wlo0 + w * A.wstep_lo, A.t_lo), whi = min(A.whi0 + w * A.wstep, A.t_hi);
    const int qrow = A.q_row0 + 64 * w;
    bf16x8 qf[2][NKK];
#pragma unroll
    for (int qb = 0; qb < 2; ++qb)
#pragma unroll
        for (int kk = 0; kk < NKK; ++kk) qf[qb][kk] = *(const bf16x8*)(A.Q + (size_t)((wlo <= whi ? qrow : A.q_row0) + 32 * qb + r32) * A.q_stride + 16 * kk + 8 * hi);
    if (DQ == 96) {
#pragma unroll
        for (int qb = 0; qb < 2; ++qb) {
            const int row = (wlo <= whi ? qrow : A.q_row0) + 32 * qb + r32; const int pos = row < NPROMPT ? (row & (SEQ - 1)) : PAST + ((row - NPROMPT) & 31);
            const float* rp = A.rope + (size_t)pos * 32 + 8 * hi;
            const f32x4 c0 = *(const f32x4*)rp, c1 = *(const f32x4*)(rp + 4), s0 = *(const f32x4*)(rp + 16), s1 = *(const f32x4*)(rp + 20);
            u32x4 w1, w2;
#pragma unroll
            for (int jp = 0; jp < 4; ++jp) {
                float o1[2], o2[2];
#pragma unroll
                for (int e = 0; e < 2; ++e) { const int j = 2 * jp + e;
                    const float x1 = __builtin_bit_cast(float, (unsigned)(unsigned short)qf[qb][NKK - 2][j] << 16), x2 = __builtin_bit_cast(float, (unsigned)(unsigned short)qf[qb][NKK - 1][j] << 16);
                    const float c = j < 4 ? c0[j & 3] : c1[j & 3], s = j < 4 ? s0[j & 3] : s1[j & 3];
                    o1[e] = x1 * c - x2 * s; o2[e] = x1 * s + x2 * c; }
                w1[jp] = pk2(o1[0], o1[1]); w2[jp] = pk2(o2[0], o2[1]);
            }
            qf[qb][NKK - 2] = __builtin_bit_cast(bf16x8, w1); qf[qb][NKK - 1] = __builtin_bit_cast(bf16x8, w2);
        }
    }
    f32x16 o[2][2];
#pragma unroll
    for (int d = 0; d < 2; ++d)
#pragma unroll
        for (int qb = 0; qb < 2; ++qb)
#pragma unroll
            for (int i = 0; i < 16; ++i) o[d][qb][i] = 0.f;
    float mrun[2] = {A.m0, A.m0}, lrun[2] = {hi == 0 ? A.l0 : 0.f, hi == 0 ? A.l0 : 0.f};
    const int lkey = tid >> 3, lpc = tid & 7, l2key = tid >> 2, l2pc = tid & 3;
    u32x4 kreg, k2reg, vreg;
    auto gload = [&](int t) {
        const size_t row = (size_t)(A.k_row0 + 64 * t);
        kreg = *(const u32x4*)(A.K + (row + lkey) * A.k_stride + 8 * lpc);
        vreg = *(const u32x4*)(A.V + (row + lkey) * A.v_stride + 8 * lpc);
        if (DQ == 96 && tid < 256) k2reg = *(const u32x4*)(A.K2 + (row + l2key) * 32 + 8 * l2pc);
    };
    auto lstore = [&](int buf) {
        LAS unsigned char* kb = lds + buf * OKBUF; LAS unsigned char* vb = lds + 2 * OKBUF + buf * OVBUF;
        *(LAS u32x4*)(kb + (lkey * OKSTR + 8 * lpc) * 2) = kreg;
        if (DQ == 96 && tid < 256) *(LAS u32x4*)(kb + (l2key * OKSTR + 64 + 8 * l2pc) * 2) = k2reg;
        LAS unsigned short* vt = (LAS unsigned short*)vb + (8 * lpc) * OVSTR + lkey;
#pragma unroll
        for (int j = 0; j < 4; ++j) { const unsigned wv = vreg[j]; vt[(2 * j) * OVSTR] = (unsigned short)(wv & 0xffffu); vt[(2 * j + 1) * OVSTR] = (unsigned short)(wv >> 16); }
    };
    gload(A.t_lo); lstore(0);
    __syncthreads();
    int buf = 0;
    for (int t = A.t_lo; t <= A.t_hi; ++t) {
        const bool more = t < A.t_hi;
        if (more) gload(t + 1);
        if (t >= wlo && t <= whi) {
            LAS unsigned char* kb = lds + buf * OKBUF; LAS unsigned char* vb = lds + 2 * OKBUF + buf * OVBUF;
            f32x16 s[2][2];
#pragma unroll
            for (int kbk = 0; kbk < 2; ++kbk) {
#pragma unroll
                for (int qb = 0; qb < 2; ++qb)
#pragma unroll
                    for (int i = 0; i < 16; ++i) s[kbk][qb][i] = 0.f;
#pragma unroll
                for (int kk = 0; kk < NKK; ++kk) {
                    const bf16x8 kf = *(const LAS bf16x8*)(kb + ((32 * kbk + r32) * OKSTR + 16 * kk + 8 * hi) * 2);
                    s[kbk][0] = MFMA32(kf, qf[0][kk], s[kbk][0]);
                    s[kbk][1] = MFMA32(kf, qf[1][kk], s[kbk][1]);
                }
            }
#pragma unroll
            for (int qb = 0; qb < 2; ++qb) {
                const int qk = A.q_kidx0 + 64 * w + 32 * qb + r32;
                float mx = -3.0e38f;
#pragma unroll
                for (int kbk = 0; kbk < 2; ++kbk)
#pragma unroll
                    for (int i = 0; i < 16; ++i) {
                        const int kidx = 64 * t + 32 * kbk + crow(i, hi);
                        float v = s[kbk][qb][i] * A.scale2;
                        if (BIAS) v += lut[kidx - qk + LUT0];
                        if (kidx >= A.nkeys) v = -1.0e30f;
                        s[kbk][qb][i] = v; mx = fmaxf(mx, v);
                    }
                mx = fmaxf(mx, xhalf(mx, hi));
                const float mnew = fmaxf(mrun[qb], mx), alpha = __builtin_amdgcn_exp2f(mrun[qb] - mnew);
                mrun[qb] = mnew;
                float ls = 0.f;
#pragma unroll
                for (int kbk = 0; kbk < 2; ++kbk)
#pragma unroll
                    for (int i = 0; i < 16; ++i) { const float p = __builtin_amdgcn_exp2f(s[kbk][qb][i] - mnew); s[kbk][qb][i] = p; ls += p; }
                lrun[qb] = lrun[qb] * alpha + ls;
#pragma unroll
                for (int d = 0; d < 2; ++d)
#pragma unroll
                    for (int i = 0; i < 16; ++i) o[d][qb][i] *= alpha;
            }
#pragma unroll
            for (int kbk = 0; kbk < 2; ++kbk)
#pragma unroll
                for (int st = 0; st < 2; ++st) {
                    bf16x8 pf[2];
#pragma unroll
                    for (int qb = 0; qb < 2; ++qb) { u32x4 pw;
#pragma unroll
                        for (int j = 0; j < 4; ++j) pw[j] = pk2c(s[kbk][qb][8 * st + 2 * j], s[kbk][qb][8 * st + 2 * j + 1]);
                        pf[qb] = __builtin_bit_cast(bf16x8, pw); }
#pragma unroll
                    for (int d = 0; d < 2; ++d) {
                        const LAS unsigned char* vp = vb + ((32 * d + r32) * OVSTR + 32 * kbk + 16 * st + 4 * hi) * 2;
                        const s16x4 lo4 = *(const LAS s16x4*)vp, hi4 = *(const LAS s16x4*)(vp + 16);
                        const bf16x8 vf = __builtin_shufflevector(lo4, hi4, 0, 1, 2, 3, 4, 5, 6, 7);
                        o[d][0] = MFMA32(vf, pf[0], o[d][0]);
                        o[d][1] = MFMA32(vf, pf[1], o[d][1]);
                    }
                }
        }
        if (more) lstore(buf ^ 1);
        __syncthreads();
        buf ^= 1;
    }
    if (wlo <= whi) {
#pragma unroll
        for (int qb = 0; qb < 2; ++qb) {
            const float lt = lrun[qb] + xhalf(lrun[qb], hi); const float inv = 1.0f / lt;
            const int qi = 32 * qb + r32;
            if (qi < A.nq_valid) {
                bf16* op = A.O + (size_t)(qrow + qi) * 1024;
#pragma unroll
                for (int d = 0; d < 2; ++d)
#pragma unroll
                    for (int g = 0; g < 4; ++g) { u32x2 wv; wv.x = pk2(o[d][qb][4 * g] * inv, o[d][qb][4 * g + 1] * inv); wv.y = pk2(o[d][qb][4 * g + 2] * inv, o[d][qb][4 * g + 3] * inv);
                        *(u32x2*)(op + 32 * d + 8 * g + 4 * hi) = wv; }
            }
        }
    }
}


__device__ __forceinline__ void attn0_phase(ArgsP a, LAS unsigned char* lds, int wave_s_) {
    unsigned char* ws = a->ws;
    const bf16* Q0 = (const bf16*)(ws + WS_Q0); const bf16* KA = (const bf16*)(ws + WS_KA); const bf16* VA = (const bf16*)(ws + WS_VA);
    const bf16* KB = (const bf16*)(ws + WS_KB); const bf16* VB = (const bf16*)(ws + WS_VB); bf16* O = (bf16*)(ws + WS_H);
    const float* lutA = (const float*)(ws + WS_LUTA); const float* lutB = (const float*)(ws + WS_LUTB); const float* sinks = a->in[21];
    constexpr int NI = 512 + 512 + 128 + 128;
    for (int it = BIDX(); it < NI; it += GDIM()) {
        AttnItem A; A.K2 = nullptr; A.rope = nullptr; A.q_stride = 1024; A.scale2 = 0.125f * LOG2E;
        if (it < 1024) {
            const bool isA = it < 512; const int r = it & 511, cgp = r & 31, h = (r >> 5) & 7, b = r >> 8;
            A.Q = Q0 + (isA ? 0 : 512) + h * 64; A.O = O + (isA ? 0 : 512) + h * 64;
            if (isA) { A.K = KA + h * 64; A.V = VA + h * 64; A.k_stride = A.v_stride = 512; A.lut = lutA + h * LUTN; A.m0 = -1.0e30f; A.l0 = 0.f; }
            else { A.K = KB + (h >> 2) * 64; A.V = VB + (h >> 2) * 64; A.k_stride = A.v_stride = 128; A.lut = lutB + h * LUTN; A.m0 = sinks[h] * LOG2E; A.l0 = 1.f; }
            const int prev = isA ? 8 : 2;
            A.q_row0 = b * SEQ + cgp * 512; A.nq_valid = 64; A.k_row0 = b * SEQ; A.q_kidx0 = cgp * 512;
            A.t_lo = max(0, 8 * cgp - prev); A.t_hi = 8 * cgp + 7; A.wlo0 = 8 * cgp - prev; A.whi0 = 8 * cgp; A.wstep_lo = 1; A.wstep = 1; A.nkeys = SEQ;
        } else {
            const bool isA = it < 1152; const int r = (it - 1024) & 127, h = r & 7, b = r >> 3;
            A.Q = Q0 + (isA ? 0 : 512) + h * 64; A.O = O + (isA ? 0 : 512) + h * 64;
            const int nc = isA ? LA : LB;
            if (isA) { A.K = KA + h * 64; A.V = VA + h * 64; A.k_stride = A.v_stride = 512; A.lut = lutA + h * LUTN; A.m0 = -1.0e30f; A.l0 = 0.f; }
            else { A.K = KB + (h >> 2) * 64; A.V = VB + (h >> 2) * 64; A.k_stride = A.v_stride = 128; A.lut = lutB + h * LUTN; A.m0 = sinks[h] * LOG2E; A.l0 = 1.f; }
            A.q_row0 = NPROMPT + b * 32; A.nq_valid = 32; A.k_row0 = NPROMPT + b * (nc + 32); A.q_kidx0 = nc;
            A.nkeys = nc + 32; A.t_lo = 0; A.t_hi = (A.nkeys - 1) >> 6; A.wlo0 = 0; A.whi0 = A.t_hi; A.wstep_lo = 0; A.wstep = -100000;
        }
        attn_item_l0<64, true>(A, lds, wave_s_);
    }
}
__device__ __forceinline__ void attn1_phase(ArgsP a, LAS unsigned char* lds, int wave_s_) {
    unsigned char* ws = a->ws;
    const bf16* QC = (const bf16*)(ws + WS_QC); const bf16* KC = (const bf16*)(ws + WS_KC); const bf16* VC = (const bf16*)(ws + WS_VC); const bf16* KR = (const bf16*)(ws + WS_KR);
    bf16* O = (bf16*)(ws + WS_H);
    constexpr int NI = 1024 + 256;
    for (int it = BIDX(); it < NI; it += GDIM()) {
        AttnItem A; A.q_stride = 1536; A.k_stride = A.v_stride = 1024; A.K2 = KR; A.rope = (const float*)(ws + WS_ROPE); A.lut = nullptr; A.m0 = 0.f; A.l0 = 0.f; A.scale2 = 0.10206207261596577f * LOG2E;
        if (it < 1024) {
            const int j = it >> 8, blk = it & 255, bh = blk & 31, g = blk >> 5, b = bh >> 4, h = bh & 15;
            const int qt = j == 0 ? g : (j == 1 ? 15 - g : (j == 2 ? 16 + g : 31 - g));
            A.Q = QC + h * 96; A.K = KC + h * 64; A.V = VC + h * 64; A.O = O + h * 64;
            A.q_row0 = b * SEQ + qt * 512; A.nq_valid = 64; A.k_row0 = b * SEQ; A.q_kidx0 = qt * 512;
            A.t_lo = 0; A.t_hi = 8 * qt + 7; A.wlo0 = 0; A.whi0 = 8 * qt; A.wstep_lo = 0; A.wstep = 1; A.nkeys = SEQ;
        } else {
            const int r = it - 1024, h = r & 15, b = r >> 4;
            A.Q = QC + h * 96; A.K = KC + h * 64; A.V = VC + h * 64; A.O = O + h * 64;
            A.q_row0 = NPROMPT + b * 32; A.nq_valid = 32; A.k_row0 = NPROMPT + b * (PAST + 32); A.q_kidx0 = PAST;
            A.nkeys = PAST + 32; A.t_lo = 0; A.t_hi = (A.nkeys - 1) >> 6; A.wlo0 = 0; A.whi0 = A.t_hi; A.wstep_lo = 0; A.wstep = -100000;
        }
        if (it < 1024) attn_item<96, false, false>(A, lds, wave_s_); else attn_item<96, false, true>(A, lds, wave_s_);
    }
}

#define XB_TMO      128
#define XB_XCNT(j)  (256  + 64 * (j))
#define XB_XSUB(j)  (1280 + 64 * (j))
#define XB_XGEN(j)  (2304 + 64 * (j))
#define XB_TOP      3328
#define XB_TOPGEN   3392
#define XCD_BAR_WORDS 3456
#define XB_SPIN_CAP (1u << 18)

__device__ __forceinline__ unsigned xb_ld(unsigned* p)              { return __hip_atomic_load(p, __ATOMIC_RELAXED, __HIP_MEMORY_SCOPE_AGENT); }
__device__ __forceinline__ unsigned xb_add(unsigned* p, unsigned v) { return __hip_atomic_fetch_add(p, v, __ATOMIC_RELAXED, __HIP_MEMORY_SCOPE_AGENT); }
__device__ __forceinline__ unsigned xb_xcc_id() { return (unsigned)__builtin_amdgcn_s_getreg((3 << 11) | 20) & 0xFu; }
#define XB_SPIN(cond, bar) do { unsigned _sp = 0; while (cond) { __builtin_amdgcn_s_sleep(1); \
    if ((++_sp & 255u) == 0u) { if (xb_ld(&(bar)[XB_TMO])) break; if (_sp > XB_SPIN_CAP) { atomicAdd(&(bar)[XB_TMO], 1u); break; } } } } while (0)

struct XcdBarrier {
    unsigned* bar; unsigned x;
    volatile LAS unsigned* st;
};

__device__ __forceinline__ XcdBarrier xcd_barrier_post(unsigned* bar, volatile LAS unsigned* st) {
    XcdBarrier b; b.bar = bar; b.x = xb_xcc_id(); b.st = st;
    if (threadIdx.x == 0) (void)xb_add(&bar[XB_XCNT(b.x)], 1u);
    return b;
}
__device__ __forceinline__ void xcd_barrier_complete(unsigned* bar, unsigned x, unsigned& nloc, unsigned& nx) {
    const unsigned G = gridDim.x * gridDim.y * gridDim.z;
    unsigned sum, cnt, mine, sp = 0u;
    for (;;) {
        sum = 0u; cnt = 0u; mine = 0u;
#pragma unroll
        for (unsigned j = 0; j < 16; ++j) { const unsigned c = xb_ld(&bar[XB_XCNT(j)]); sum += c; cnt += (c > 0u) ? 1u : 0u; mine = (j == x) ? c : mine; }
        if (sum == G) break;
        __builtin_amdgcn_s_sleep(1);
        if ((++sp & 255u) == 0u) { if (xb_ld(&bar[XB_TMO])) break; if (sp > XB_SPIN_CAP) { atomicAdd(&bar[XB_TMO], 1u); break; } }
    }
    nloc = mine > 0u ? mine : 1u; nx = cnt > 0u ? cnt : 1u;
}

__device__ __forceinline__ void xcd_barrier(const XcdBarrier& b) {
    asm volatile("s_waitcnt vmcnt(0)" ::: "memory");
    __syncthreads();
    if (threadIdx.x == 0) {
        unsigned* bar = b.bar;
        __builtin_amdgcn_s_waitcnt(0);
        unsigned nloc = b.st[0], nx = b.st[1];
        if (nloc == 0u) { xcd_barrier_complete(bar, b.x, nloc, nx); b.st[0] = nloc; b.st[1] = nx; }
        const unsigned old = xb_add(&bar[XB_XSUB(b.x)], 1u);
        const unsigned gen = old / nloc;
        if (old + 1u == (gen + 1u) * nloc) {
            __builtin_amdgcn_fence(__ATOMIC_RELEASE, "agent");
            asm volatile("s_waitcnt vmcnt(0)" ::: "memory");
            const unsigned og = xb_add(&bar[XB_TOP], 1u);
            const unsigned tg = og / nx;
            if (og + 1u == (tg + 1u) * nx) xb_add(&bar[XB_TOPGEN], 1u);
            else XB_SPIN(xb_ld(&bar[XB_TOPGEN]) == tg, bar);
            __builtin_amdgcn_fence(__ATOMIC_ACQUIRE, "agent");
            xb_add(&bar[XB_XGEN(b.x)], 1u);
            asm volatile("s_waitcnt vmcnt(0)" ::: "memory");
        } else {
            XB_SPIN(xb_ld(&bar[XB_XGEN(b.x)]) == gen, bar);
            __builtin_amdgcn_fence(__ATOMIC_ACQUIRE, "agent");
            asm volatile("s_waitcnt vmcnt(0)" ::: "memory");
        }
    }
    __syncthreads();
}

template <class Epi>
__device__ __forceinline__ void run_gemm(LAS unsigned char* lds, const bf16* A_, const bf16* Bt, int M, int N, int K, const Epi& E, int wave_s_, int Mfull = -1, int nsplit = 1) {
    const int gd = GDIM(), bx = BIDX();
    pg8::Gemm g{A_, Bt, M, N, K}; pg8::StaticOrder S; S.init(M, N, K, gd, bx, Mfull, nsplit);
    pg8::gemm_phase<Epi, pg8::StaticOrder, true, true>(lds, g, S, E, wave_s_);
}
__device__ __forceinline__ void ffn_up_phase(LAS unsigned char* lds, int idx, int wave_s_) {
    ArgsP a = get_args(); unsigned char* ws = a->ws;
    pg8::EpiGU E{(bf16*)(ws + WS_HID)}; run_gemm(lds, (const bf16*)(ws + WS_H), (const bf16*)(ws + WS_WGU + (size_t)idx * SZ_WGU), R, 2 * DFF, DM, E, wave_s_);
}
__device__ __forceinline__ void ffn_down_phase(LAS unsigned char* lds, int idx, int l, int gi, int wave_s_) {
    ArgsP a = get_args(); unsigned char* ws = a->ws;
    pg8::EpiRes E{a->out, ws, (idx == 0 ? a->in[0] : nullptr), gi * DM | (l << 16), 0.5f}; run_gemm(lds, (const bf16*)(ws + WS_HID), (const bf16*)(ws + WS_WD + (size_t)idx * SZ_WD), R, DM, DFF, E, wave_s_, NPROMPT, 11);
}
__device__ __forceinline__ void oproj_phase(LAS unsigned char* lds, int l, int wave_s_) {
    ArgsP a = get_args(); unsigned char* ws = a->ws;
    pg8::EpiRes E{a->out, ws, nullptr, 5 * DM | (l << 16), 1.0f}; run_gemm(lds, (const bf16*)(ws + WS_H), (const bf16*)(ws + (l == 0 ? WS_WOAB : WS_WOC)), R, DM, DM, E, wave_s_, NPROMPT, 4);
}
__device__ __forceinline__ void norm_phase(int l, int which, int wave_s_, bool fold = true) {
    ArgsP a = get_args();
    norm_mod_phase(a, l == 0 && which == 0, a->in[12] + (size_t)(l * 3 + which) * DM, (const float*)(a->ws + WS_MODS) + (size_t)l * NSEQ * NMOD, 3 * which, 3 * which + 1,
                   !fold ? 0 : (which == 2 ? 4 : (l == 0 && which == 0 ? 0 : 11)), wave_s_);
}

__global__ void __launch_bounds__(NT, 2) fwd_megakernel(Args a_unused) {
    extern __shared__ __attribute__((aligned(16))) unsigned char lds_raw[];
    LAS unsigned char* lds = (LAS unsigned char*)lds_raw;
    cg::grid_group grid = cg::this_grid();
    if (threadIdx.x < 4) ((LAS unsigned*)(lds + LDS_BYTES - 16))[threadIdx.x] = 0u;
    __syncthreads();
    (void)xcd_barrier_post((unsigned*)(get_args()->ws + WS_CTL), (volatile LAS unsigned*)(lds + LDS_BYTES - 16));
#define GRID_BAR() do { XcdBarrier b_; b_.bar = (unsigned*)(get_args()->ws + WS_CTL); b_.x = xb_xcc_id(); b_.st = (volatile LAS unsigned*)(lds + LDS_BYTES - 16); xcd_barrier(b_); } while (0)
    const int wave_s_ = __builtin_amdgcn_readfirstlane((int)threadIdx.x >> 6);
    prologue(get_args(), lds, wave_s_);
    grid.sync();
#pragma unroll 1
    for (int l = 0; l < 2; ++l) {
        norm_phase(l, 0, wave_s_); GRID_BAR();
        ffn_up_phase(lds, 2 * l, wave_s_); GRID_BAR();
        ffn_down_phase(lds, 2 * l, l, 2, wave_s_); GRID_BAR();
        norm_phase(l, 1, wave_s_);
        if (l == 0) {
            {
                ArgsP a = get_args(); unsigned char* ws = a->ws; const int gtid = BIDX() * NT + TIDX(), gthreads = GDIM() * NT;
                cvt_rows(a->in[4], (bf16*)(ws + WS_KA), 16, LA, 512, NPROMPT, LA + 32, gtid, gthreads);
                cvt_rows(a->in[5], (bf16*)(ws + WS_VA), 16, LA, 512, NPROMPT, LA + 32, gtid, gthreads);
                cvt_rows(a->in[6], (bf16*)(ws + WS_KB), 16, LB, 128, NPROMPT, LB + 32, gtid, gthreads);
                cvt_rows(a->in[7], (bf16*)(ws + WS_VB), 16, LB, 128, NPROMPT, LB + 32, gtid, gthreads);
                zero16(ws + WS_KA + (size_t)KA_ROWS * 512 * 2, 64 * 512 * 2 / 16, gtid, gthreads); zero16(ws + WS_VA + (size_t)KA_ROWS * 512 * 2, 64 * 512 * 2 / 16, gtid, gthreads);
                zero16(ws + WS_KB + (size_t)KB_ROWS * 128 * 2, 64 * 128 * 2 / 16, gtid, gthreads); zero16(ws + WS_VB + (size_t)KB_ROWS * 128 * 2, 64 * 128 * 2 / 16, gtid, gthreads);
            }
            GRID_BAR();
            {   ArgsP a = get_args(); unsigned char* ws = a->ws;
                pg8::EpiQKV E{(bf16*)(ws + WS_Q0), (bf16*)(ws + WS_KA), (bf16*)(ws + WS_VA), (bf16*)(ws + WS_KB), (bf16*)(ws + WS_VB), a->out};
                run_gemm(lds, (const bf16*)(ws + WS_H), (const bf16*)(ws + WS_WAB), R, 2304, DM, E, wave_s_); }
            GRID_BAR();
            attn0_phase(get_args(), lds, wave_s_);
            GRID_BAR();
        } else {
            prologue_l1(get_args(), wave_s_);
            GRID_BAR();
            {   ArgsP a = get_args(); unsigned char* ws = a->ws;
                pg8::EpiF32 E{(float*)(ws + WS_CIN), 768}; run_gemm(lds, (const bf16*)(ws + WS_H), (const bf16*)(ws + WS_WCIN), R, 768, DM, E, wave_s_); }
            GRID_BAR();
            mla_norm_phase(get_args(), wave_s_);
            GRID_BAR();
            {   ArgsP a = get_args(); unsigned char* ws = a->ws; const int gtid = BIDX() * NT + TIDX(), gthreads = GDIM() * NT;
                zero16(ws + WS_KC + (size_t)RKV * 1024 * 2, 64 * 1024 * 2 / 16, gtid, gthreads); zero16(ws + WS_VC + (size_t)RKV * 1024 * 2, 64 * 1024 * 2 / 16, gtid, gthreads); }
            {   ArgsP a = get_args(); unsigned char* ws = a->ws;
                pg8::EpiBF E{(bf16*)(ws + WS_QC), 1536}; run_gemm(lds, (const bf16*)(ws + WS_QN), (const bf16*)(ws + WS_WQB), R, 1536, 384, E, wave_s_); }
            {   ArgsP a = get_args(); unsigned char* ws = a->ws;
                pg8::EpiKV E{(bf16*)(ws + WS_KC), (bf16*)(ws + WS_VC)}; run_gemm(lds, (const bf16*)(ws + WS_KVN), (const bf16*)(ws + WS_WKVB), RKV, 2048, 256, E, wave_s_); }
            GRID_BAR();
            attn1_phase(get_args(), lds, wave_s_);
            GRID_BAR();
        }
        oproj_phase(lds, l, wave_s_); GRID_BAR();
        norm_phase(l, 2, wave_s_); GRID_BAR();
        ffn_up_phase(lds, 2 * l + 1, wave_s_); GRID_BAR();
        ffn_down_phase(lds, 2 * l + 1, l, 8, wave_s_); GRID_BAR();
    }
    final_norm_phase(get_args(), wave_s_);
}

extern "C" void kernel_launch(void* const* d_in, const int* in_sizes, int n_in, void* d_out, int out_size, void* d_ws, size_t ws_size, hipStream_t stream) {
    static int grid = 0;
    if (grid == 0) {
        if (n_in != 28 || out_size != (int)O_END || ws_size < WS_CTL + 16384) { fprintf(stderr, "kernel_launch: unexpected shapes n_in %d out %d ws %zu (need %zu)\n", n_in, out_size, ws_size, (size_t)(WS_CTL + 16384)); grid = -1; return; }
        int dev = 0, cus = 0, per_cu = 0;
        hipGetDevice(&dev); hipDeviceGetAttribute(&cus, hipDeviceAttributeMultiprocessorCount, dev);
        if (hipFuncSetAttribute((const void*)fwd_megakernel, hipFuncAttributeMaxDynamicSharedMemorySize, LDS_BYTES) != hipSuccess) { fprintf(stderr, "kernel_launch: hipFuncSetAttribute failed\n"); grid = -1; return; }
        if (hipOccupancyMaxActiveBlocksPerMultiprocessor(&per_cu, (const void*)fwd_megakernel, NT, LDS_BYTES) != hipSuccess || per_cu < 1) { fprintf(stderr, "kernel_launch: occupancy query says %d\n", per_cu); per_cu = 1; }
        (void)hipGetLastError();
        grid = cus;
    }
    if (grid < 0) return;
    if (hipMemsetAsync((char*)d_ws + WS_CTL, 0, XCD_BAR_WORDS * 4, stream) != hipSuccess) { fprintf(stderr, "kernel_launch: hipMemsetAsync failed\n"); return; }
    Args a{};
    for (int i = 0; i < 28; ++i) a.in[i] = (const float*)d_in[i];
    a.out = (float*)d_out; a.ws = (unsigned char*)d_ws;
    void* args[] = {&a};
    hipError_t e = hipLaunchCooperativeKernel((const void*)fwd_megakernel, dim3(grid), dim3(NT), args, LDS_BYTES, stream);
    if (e != hipSuccess) fprintf(stderr, "cooperative launch failed: %s (grid %d)\n", hipGetErrorString(e), grid);
}
```

```cpp
#include <hip/hip_runtime.h>
#include <hip/hip_cooperative_groups.h>
#include <cstdio>
#include <cstdint>
namespace cg = cooperative_groups;

constexpr int DM = 1024, SEQ = 16384, NPROMPT = 2 * SEQ, NSAMP = 16 * 32, R = NPROMPT + NSAMP;
constexpr int DFF = 2816, NSEQ = 18, NMOD = 9 * DM;
constexpr int LA = 512, LB = 128, PAST = 1024;
constexpr int KA_ROWS = NPROMPT + 16 * (LA + 32);
constexpr int KB_ROWS = NPROMPT + 16 * (LB + 32);
constexpr int RKV = NPROMPT + 16 * (PAST + 32);
constexpr int LUTN = 1280, LUT0 = 640;
constexpr float LOG2E = 1.4426950408889634f;
constexpr float EPS = 1e-6f;

constexpr size_t O_YP = 0, O_YS = O_YP + (size_t)NPROMPT * DM, O_AKP = O_YS + (size_t)NSAMP * DM, O_AVP = O_AKP + 2 * 512 * 512,
                 O_BKP = O_AVP + 2 * 512 * 512, O_BVP = O_BKP + 2 * 128 * 128, O_CKVP = O_BVP + 2 * 128 * 128, O_CKRP = O_CKVP + (size_t)NPROMPT * 256,
                 O_AKS = O_CKRP + (size_t)NPROMPT * 32, O_AVS = O_AKS + 512 * 512, O_BKS = O_AVS + 512 * 512, O_BVS = O_BKS + 512 * 128,
                 O_CKVS = O_BVS + 512 * 128, O_CKRS = O_CKVS + 512 * 256, O_END = O_CKRS + 512 * 32;
static_assert(O_END == 45432832, "d_out size");

constexpr size_t al256(size_t x) { return (x + 255) & ~(size_t)255; }
constexpr size_t SZ_WGU = (size_t)2 * DFF * DM * 2, SZ_WD = (size_t)DM * DFF * 2;
constexpr size_t WS_WGU = 0;
constexpr size_t WS_WD = WS_WGU + 4 * SZ_WGU;
constexpr size_t WS_WAB = WS_WD + 4 * SZ_WD;
constexpr size_t WS_WOAB = WS_WAB + (size_t)2304 * 1024 * 2;
constexpr size_t WS_WCIN = WS_WOAB + (size_t)1024 * 1024 * 2;
constexpr size_t WS_WQB = WS_WCIN + (size_t)768 * 1024 * 2;
constexpr size_t WS_WKVB = WS_WQB + (size_t)1536 * 384 * 2;
constexpr size_t WS_WOC = WS_WKVB + (size_t)2048 * 256 * 2;
constexpr size_t WS_MODS = WS_WOC + (size_t)1024 * 1024 * 2;
constexpr size_t WS_ROPE = WS_MODS + (size_t)2 * NSEQ * NMOD * 4;
constexpr size_t WS_LUTA = WS_ROPE + (size_t)SEQ * 32 * 4;
constexpr size_t WS_LUTB = WS_LUTA + (size_t)8 * LUTN * 4;
constexpr size_t WS_H = al256(WS_LUTB + (size_t)8 * LUTN * 4);
constexpr size_t WS_OV = al256(WS_H + (size_t)(R + 64) * DM * 2);
constexpr size_t WS_HID = WS_OV;
constexpr size_t WS_PART = al256(WS_HID + (size_t)R * DFF * 2);
constexpr size_t WS_Q0 = WS_OV;
constexpr size_t WS_KA = al256(WS_Q0 + (size_t)(R + 64) * 1024 * 2);
constexpr size_t WS_VA = al256(WS_KA + (size_t)(KA_ROWS + 64) * 512 * 2);
constexpr size_t WS_KB = al256(WS_VA + (size_t)(KA_ROWS + 64) * 512 * 2);
constexpr size_t WS_VB = al256(WS_KB + (size_t)(KB_ROWS + 64) * 128 * 2);
constexpr size_t WS_L0END = al256(WS_VB + (size_t)(KB_ROWS + 64) * 128 * 2);
constexpr size_t WS_QN = WS_OV;
constexpr size_t WS_KVN = al256(WS_QN + (size_t)R * 384 * 2);
constexpr size_t WS_KR = al256(WS_KVN + (size_t)RKV * 256 * 2);
constexpr size_t WS_QC = al256(WS_KR + (size_t)(RKV + 64) * 32 * 2);
constexpr size_t WS_KC = al256(WS_QC + (size_t)(R + 64) * 1536 * 2);
constexpr size_t SZ_KC = (size_t)(RKV + 64) * 1024 * 2 > (size_t)R * 768 * 4 ? (size_t)(RKV + 64) * 1024 * 2 : (size_t)R * 768 * 4;
constexpr size_t WS_CIN = WS_KC;
constexpr size_t WS_VC = al256(WS_KC + SZ_KC);
constexpr size_t WS_L1END = al256(WS_VC + (size_t)(RKV + 64) * 1024 * 2);
constexpr size_t WS_TOTAL = WS_L1END > WS_L0END ? WS_L1END : WS_L0END;
static_assert(WS_PART + (size_t)11 * NSAMP * DM * 4 <= WS_TOTAL && WS_PART >= WS_L0END && WS_PART >= WS_QC, "hid + partials fit; partials clear of the layer-0 buffers and of QN/KVN/KR");
constexpr size_t WS_CTL = WS_TOTAL;
static_assert(WS_CTL + 16384 <= (size_t)512 * 1024 * 1024, "workspace fits 4x largest tensor");

__device__ __forceinline__ int tidx_from(int wv);
namespace pg8 {
#define PG8_LAS __attribute__((address_space(3)))
typedef unsigned short bf16_t;
typedef short bf16x8 __attribute__((ext_vector_type(8)));
typedef float f32x4 __attribute__((ext_vector_type(4)));
typedef unsigned u32x4 __attribute__((ext_vector_type(4)));
constexpr int BM = 256, BK = 64, HALF = 128, HTB = HALF * BK * 2  , STAGE_BYTES = 8 * HTB, NXCD = 8, WGM = 8;

__host__ __device__ __forceinline__ int lds_byte(int r, int c) { const int st = (r >> 4) * 2 + (c >> 5), rr = r & 15, cc = c & 31, ob = rr * 64 + cc * 2; return st * 1024 + (ob ^ (((ob >> 9) & 1) << 5)); }
__host__ __device__ __forceinline__ void stage_rc(int b, int& R, int& C) { const int st = b / 1024, sb = b % 1024, swz = sb ^ (((sb >> 9) & 1) << 5); R = (st >> 1) * 16 + swz / 64; C = (st & 1) * 32 + (swz % 64) / 2; }
__host__ __device__ __forceinline__ int perm32(int rho) { const int n = rho >> 4, i = rho & 15; return 8 * (i >> 2) + 4 * n + (i & 3); }

struct Unit { int pm, pn; };
struct Gemm { const bf16_t* A; const bf16_t* Bt; int M, N, K; };

struct StaticOrder {
    int nM, nN, nwg, G, c, kt, ntail, nsplit, ktper;
    __host__ __device__ __forceinline__ void init(int M, int N, int K, int G_, int c_, int Mfull = -1, int nsplit_ = 1) { if (Mfull < 0) Mfull = M; nM = Mfull / BM; nN = N / BM; nwg = nM * nN; G = G_; c = c_; kt = K / BK;
        ntail = ((M - Mfull) / BM) * nN; nsplit = nsplit_; ktper = kt / nsplit_; }
    __host__ __device__ __forceinline__ bool next(int i, Unit& u) const {
        const long L = (long)i * G + c;
        if (L >= nwg) { const long e = L - nwg; if (e >= (long)ntail * nsplit) return false; const int tu = (int)(e / nsplit), sl = (int)(e % nsplit);
            u.pm = (nM + tu / nN) | ((sl + 1) << 12); u.pn = tu % nN; return true; }
        int wgid = (int)L; { const int q = nwg / NXCD, r = nwg % NXCD, xcd = wgid % NXCD, off = wgid / NXCD; wgid = (xcd < r ? xcd * (q + 1) : r * (q + 1) + (xcd - r) * q) + off; }
        const int nig = WGM * nN, gid = wgid / nig, fm = gid * WGM, gsz = (nM - fm) < WGM ? (nM - fm) : WGM;
        u.pm = fm + ((wgid % nig) % gsz); u.pn = (wgid % nig) / gsz; return true;
    }
    __device__ __forceinline__ int k0_of(const Unit& u) const { const int s = u.pm >> 12; return s ? (s - 1) * ktper : 0; }
    __device__ __forceinline__ int nt_of(const Unit& u) const { return (u.pm >> 12) ? ktper : kt; }
    __device__ __forceinline__ void a_ready(const Unit&) const {}
    __device__ __forceinline__ void done(const Unit&) const {}
};

__device__ __forceinline__ unsigned cvt_pk_bf16(float lo, float hi) { unsigned r; asm volatile("v_cvt_pk_bf16_f32 %0, %1, %2" : "=v"(r) : "v"(lo), "v"(hi)); return r; }
typedef unsigned u32x2 __attribute__((ext_vector_type(2)));
__device__ __forceinline__ int cidx_of(int r) { return r < NPROMPT ? (r >> 14) : 2 + ((r - NPROMPT) >> 5); }
__device__ __forceinline__ float silu_f(float x) { return x * __builtin_amdgcn_rcpf(1.0f + __expf(-x)); }
__device__ __forceinline__ u32x4 pack8(const f32x4& a, const f32x4& b) { u32x4 w; w.x = cvt_pk_bf16(a[0], a[1]); w.y = cvt_pk_bf16(a[2], a[3]); w.z = cvt_pk_bf16(b[0], b[1]); w.w = cvt_pk_bf16(b[2], b[3]); return w; }

struct EpiGU {
    static constexpr bool PERM = true, AFTER_DRAIN = false;
    bf16_t* HID;
    __device__ __forceinline__ void operator()(const f32x4 (&acc)[2][2][4][2], const Unit& u, int wr, int wc, int fr, int fq) const {
        { int l_; asm volatile("v_mbcnt_lo_u32_b32 %0, -1, 0\n\tv_mbcnt_hi_u32_b32 %0, -1, %0" : "=v"(l_)); fr = l_ & 15; fq = (l_ >> 4) & 3; }
        const int row0 = u.pm * BM + wr * 64 + fr, col0 = u.pn * 128 + wc * 32 + 8 * fq;
#pragma unroll
        for (int ai = 0; ai < 2; ++ai)
#pragma unroll
            for (int m = 0; m < 4; ++m) {
                f32x4 h0, h1;
#pragma unroll
                for (int j = 0; j < 4; ++j) { h0[j] = silu_f(acc[ai][0][m][0][j]) * acc[ai][1][m][0][j]; h1[j] = silu_f(acc[ai][0][m][1][j]) * acc[ai][1][m][1][j]; }
                *(u32x4*)(HID + (size_t)(row0 + ai * HALF + m * 16) * DFF + col0) = pack8(h0, h1);
            }
    }
};
struct EpiRes {
    static constexpr bool PERM = false, AFTER_DRAIN = false;
    float* X; unsigned char* ws; const float* Xin; int goff_l; float fac;
    __device__ __forceinline__ void operator()(const f32x4 (&acc)[2][2][4][2], const Unit& u, int wr, int wc, int fr, int fq) const {
        { int l_; asm volatile("v_mbcnt_lo_u32_b32 %0, -1, 0\n\tv_mbcnt_hi_u32_b32 %0, -1, %0" : "=v"(l_)); fr = l_ & 15; fq = (l_ >> 4) & 3; }
        const int slice = u.pm >> 12, row0 = (u.pm & 4095) * BM + wr * 64 + fr, col0 = u.pn * BM + wc * 32 + 4 * fq;
        const float* mods = (const float*)(ws + WS_MODS) + (size_t)(goff_l >> 16) * NSEQ * NMOD; const int goff = goff_l & 0xffff; float* PART = (float*)(ws + WS_PART);
#pragma unroll
        for (int ai = 0; ai < 2; ++ai)
#pragma unroll
            for (int mp = 0; mp < 4; mp += 2) {
                f32x4 gv[2][4], xv[2][4];
#pragma unroll
                for (int mm = 0; mm < 2; ++mm) {
                    const int row = row0 + ai * HALF + (mp + mm) * 16; const float* gp = mods + (size_t)cidx_of(row) * NMOD + goff + col0;
                    const float* xs = ((Xin && row < NPROMPT) ? Xin + (size_t)row * DM : X + (size_t)row * DM) + col0;
#pragma unroll
                    for (int q4 = 0; q4 < 4; ++q4) { const int co = (q4 >> 1) * HALF + (q4 & 1) * 16; gv[mm][q4] = *(const f32x4*)(gp + co); if (!slice) xv[mm][q4] = *(const f32x4*)(xs + co); }
                }
#pragma unroll
                for (int mm = 0; mm < 2; ++mm) {
                    const int row = row0 + ai * HALF + (mp + mm) * 16;
#pragma unroll
                    for (int q4 = 0; q4 < 4; ++q4) { const int co = (q4 >> 1) * HALF + (q4 & 1) * 16; const f32x4 d = (gv[mm][q4] * fac) * acc[ai][q4 >> 1][mp + mm][q4 & 1];
                        if (slice) *(f32x4*)(PART + ((size_t)(slice - 1) * NSAMP + (row - NPROMPT)) * DM + col0 + co) = d;
                        else *(f32x4*)(X + (size_t)row * DM + col0 + co) = xv[mm][q4] + d; }
                }
                asm volatile("" ::: "memory");
            }
    }
};
struct EpiQKV {
    static constexpr bool PERM = true, AFTER_DRAIN = false;
    bf16_t *Q0, *KA, *VA, *KB, *VB; float* out;
    __device__ __forceinline__ void operator()(const f32x4 (&acc)[2][2][4][2], const Unit& u, int wr, int wc, int fr, int fq) const {
        { int l_; asm volatile("v_mbcnt_lo_u32_b32 %0, -1, 0\n\tv_mbcnt_hi_u32_b32 %0, -1, %0" : "=v"(l_)); fr = l_ & 15; fq = (l_ >> 4) & 3; }
        const int row0 = u.pm * BM + wr * 64 + fr;
#pragma unroll
        for (int bj = 0; bj < 2; ++bj) {
            const int cbase = u.pn * BM + bj * HALF, reg = cbase >> 7, cw = wc * 32 + 8 * fq;
#pragma unroll
            for (int ai = 0; ai < 2; ++ai)
#pragma unroll
                for (int m = 0; m < 4; ++m) {
                    const int row = row0 + ai * HALF + m * 16; const f32x4 v0 = acc[ai][bj][m][0], v1 = acc[ai][bj][m][1]; const u32x4 w = pack8(v0, v1);
                    const bool isp = row < NPROMPT; const int b = isp ? (row >> 14) : ((row - NPROMPT) >> 5), s = isp ? (row & (SEQ - 1)) : ((row - NPROMPT) & 31);
                    if (reg < 4) { *(u32x4*)(Q0 + (size_t)row * 1024 + cbase + cw) = w; }
                    else if (reg < 12) {
                        const bool isk = reg < 8; const int c = cbase - (isk ? 512 : 1024) + cw;
                        const int kr = isp ? row : NPROMPT + b * (LA + 32) + LA + s;
                        *(u32x4*)((isk ? KA : VA) + (size_t)kr * 512 + c) = w;
                        float* o = nullptr;
                        if (isp) { if (s >= SEQ - LA) o = out + (isk ? O_AKP : O_AVP) + (size_t)(b * LA + s - (SEQ - LA)) * 512 + c; }
                        else o = out + (isk ? O_AKS : O_AVS) + (size_t)(row - NPROMPT) * 512 + c;
                        if (o) { *(f32x4*)o = v0; *(f32x4*)(o + 4) = v1; }
                    } else if (reg < 16) { *(u32x4*)(Q0 + (size_t)row * 1024 + 512 + (cbase - 1536) + cw) = w; }
                    else {
                        const bool isk = reg == 16; const int c = cw;
                        const int kr = isp ? row : NPROMPT + b * (LB + 32) + LB + s;
                        *(u32x4*)((isk ? KB : VB) + (size_t)kr * 128 + c) = w;
                        float* o = nullptr;
                        if (isp) { if (s >= SEQ - LB) o = out + (isk ? O_BKP : O_BVP) + (size_t)(b * LB + s - (SEQ - LB)) * 128 + c; }
                        else o = out + (isk ? O_BKS : O_BVS) + (size_t)(row - NPROMPT) * 128 + c;
                        if (o) { *(f32x4*)o = v0; *(f32x4*)(o + 4) = v1; }
                    }
                }
        }
    }
};
struct EpiF32 {
    static constexpr bool PERM = false, AFTER_DRAIN = false;
    float* C; int ldc;
    __device__ __forceinline__ void operator()(const f32x4 (&acc)[2][2][4][2], const Unit& u, int wr, int wc, int fr, int fq) const {
        { int l_; asm volatile("v_mbcnt_lo_u32_b32 %0, -1, 0\n\tv_mbcnt_hi_u32_b32 %0, -1, %0" : "=v"(l_)); fr = l_ & 15; fq = (l_ >> 4) & 3; }
        const int row0 = u.pm * BM + wr * 64 + fr, col0 = u.pn * BM + wc * 32 + 4 * fq;
#pragma unroll
        for (int ai = 0; ai < 2; ++ai)
#pragma unroll
            for (int m = 0; m < 4; ++m) { float* xp = C + (size_t)(row0 + ai * HALF + m * 16) * ldc;
#pragma unroll
                for (int bj = 0; bj < 2; ++bj)
#pragma unroll
                    for (int n = 0; n < 2; ++n) *(f32x4*)(xp + col0 + bj * HALF + n * 16) = acc[ai][bj][m][n]; }
    }
};
struct EpiBF {
    static constexpr bool PERM = true, AFTER_DRAIN = false;
    bf16_t* C; int ldc;
    __device__ __forceinline__ void operator()(const f32x4 (&acc)[2][2][4][2], const Unit& u, int wr, int wc, int fr, int fq) const {
        { int l_; asm volatile("v_mbcnt_lo_u32_b32 %0, -1, 0\n\tv_mbcnt_hi_u32_b32 %0, -1, %0" : "=v"(l_)); fr = l_ & 15; fq = (l_ >> 4) & 3; }
        const int row0 = u.pm * BM + wr * 64 + fr, col0 = u.pn * BM + wc * 32 + 8 * fq;
#pragma unroll
        for (int ai = 0; ai < 2; ++ai)
#pragma unroll
            for (int m = 0; m < 4; ++m) { bf16_t* xp = C + (size_t)(row0 + ai * HALF + m * 16) * ldc + col0;
#pragma unroll
                for (int bj = 0; bj < 2; ++bj) *(u32x4*)(xp + bj * HALF) = pack8(acc[ai][bj][m][0], acc[ai][bj][m][1]); }
    }
};
struct EpiKV {
    static constexpr bool PERM = true, AFTER_DRAIN = false;
    bf16_t *KC, *VC;
    __device__ __forceinline__ void operator()(const f32x4 (&acc)[2][2][4][2], const Unit& u, int wr, int wc, int fr, int fq) const {
        { int l_; asm volatile("v_mbcnt_lo_u32_b32 %0, -1, 0\n\tv_mbcnt_hi_u32_b32 %0, -1, %0" : "=v"(l_)); fr = l_ & 15; fq = (l_ >> 4) & 3; }
        const int row0 = u.pm * BM + wr * 64 + fr;
#pragma unroll
        for (int bj = 0; bj < 2; ++bj) {
            const int head = (u.pn * BM + bj * HALF) >> 7; bf16_t* dst = (wc < 2 ? KC : VC) + head * 64 + (wc & 1) * 32 + 8 * fq;
#pragma unroll
            for (int ai = 0; ai < 2; ++ai)
#pragma unroll
                for (int m = 0; m < 4; ++m) *(u32x4*)(dst + (size_t)(row0 + ai * HALF + m * 16) * 1024) = pack8(acc[ai][bj][m][0], acc[ai][bj][m][1]);
        }
    }
};
template <class Epi, class Sched, bool ALIGN_EPI = false, bool SP2 = false>
__device__ __forceinline__ void gemm_phase(PG8_LAS unsigned char* lds, const Gemm g, const Sched& S, const Epi& E, int wave_s_) {
    const int tid = tidx_from(wave_s_), wid = __builtin_amdgcn_readfirstlane(tid >> 6), lane = tid & 63, wr = wid >> 2, wc = wid & 3, fr = lane & 15, fq = lane >> 4;
    const int K = g.K;
    unsigned voffA[2], voffB[2];
#pragma unroll
    for (int i = 0; i < 2; ++i) { int R, C; stage_rc(tid * 16 + i * 8192, R, C); const int Rb = Epi::PERM ? ((R & ~31) + perm32(R & 31)) : R;
        voffA[i] = (unsigned)(R * K + C) * 2u; voffB[i] = (unsigned)(Rb * K + C) * 2u; }
    const size_t kstep = (size_t)(BK * 2);
    const size_t hstep = (size_t)HALF * K * 2;
    const size_t tstep = 2 * hstep;
    const unsigned ldsw = (unsigned)wid * 1024u;
    const int aoff = lds_byte(wr * 64 + fr, fq * 8), boff = lds_byte(wc * 32 + fr, fq * 8);
#define PG8_SA(b, h) (((b) * 2 + (h)) * HTB)
#define PG8_SB(b, h) ((4 + (b) * 2 + (h)) * HTB)
#define PG8_STAGE(bufoff, gbase, voff) do { _Pragma("unroll") for (int _i = 0; _i < 2; ++_i) \
        __builtin_amdgcn_global_load_lds((const unsigned*)((const char*)(gbase) + (voff)[_i]), (PG8_LAS unsigned*)(lds + (bufoff) + ldsw + _i * 8192), 16, 0, 0); } while (0)
#define PG8_LDA(dst, b, h) do { _Pragma("unroll") for (int m = 0; m < 4; ++m) _Pragma("unroll") for (int k = 0; k < 2; ++k) dst[m][k] = *(const PG8_LAS bf16x8*)(lds + PG8_SA(b, h) + aoff + m * 2048 + k * 1024); } while (0)
#define PG8_LDB(dst, b, h) do { _Pragma("unroll") for (int n = 0; n < 2; ++n) _Pragma("unroll") for (int k = 0; k < 2; ++k) dst[n][k] = *(const PG8_LAS bf16x8*)(lds + PG8_SB(b, h) + boff + n * 2048 + k * 1024); } while (0)
#define PG8_MMA(ai, bj, At, Bt) do { __builtin_amdgcn_s_setprio(1); _Pragma("unroll") for (int m = 0; m < 4; ++m) _Pragma("unroll") for (int n = 0; n < 2; ++n) _Pragma("unroll") for (int k = 0; k < 2; ++k) \
        acc[ai][bj][m][n] = __builtin_amdgcn_mfma_f32_16x16x32_bf16(Bt[n][k], At[m][k], acc[ai][bj][m][n], 0, 0, 0); __builtin_amdgcn_s_setprio(0); } while (0)
#define PG8_WAIT_V(n) asm volatile("s_waitcnt vmcnt(" #n ")" ::: "memory")
#define PG8_WAIT_L(n) asm volatile("s_waitcnt lgkmcnt(" #n ")" ::: "memory")
#define PG8_BAR __builtin_amdgcn_s_barrier()
#define PG8_SCHED __builtin_amdgcn_sched_barrier(0)
    Unit cur, nxt; int ui = 0;
    if (!S.next(0, cur)) return;
    f32x4 acc[2][2][4][2];
#pragma unroll
    for (int a = 0; a < 2; ++a)
#pragma unroll
        for (int b = 0; b < 2; ++b)
#pragma unroll
            for (int m = 0; m < 4; ++m)
#pragma unroll
                for (int n = 0; n < 2; ++n) acc[a][b][m][n] = (f32x4){0.f, 0.f, 0.f, 0.f};
    bf16x8 At[4][2], B0[2][2], B1[2][2];
    const char* cA = (const char*)g.A + (size_t)(cur.pm & 4095) * tstep + (size_t)S.k0_of(cur) * kstep; const char* cB = (const char*)g.Bt + (size_t)cur.pn * tstep + (size_t)S.k0_of(cur) * kstep;
    S.a_ready(cur);
    if constexpr (SP2) {
        PG8_STAGE(PG8_SB(0, 0), cB, voffB); PG8_STAGE(PG8_SB(0, 1), cB + hstep, voffB); PG8_STAGE(PG8_SA(0, 0), cA, voffA); PG8_STAGE(PG8_SA(0, 1), cA + hstep, voffA);
        if (wr == 1) PG8_BAR;
        PG8_WAIT_V(2); PG8_BAR;
        PG8_STAGE(PG8_SB(1, 0), cB + kstep, voffB); PG8_STAGE(PG8_SA(1, 0), cA + kstep, voffA); PG8_STAGE(PG8_SB(1, 1), cB + hstep + kstep, voffB);
        PG8_WAIT_V(6); PG8_BAR;
    } else {
        PG8_STAGE(PG8_SB(0, 0), cB, voffB); PG8_STAGE(PG8_SA(0, 0), cA, voffA); PG8_STAGE(PG8_SB(0, 1), cB + hstep, voffB); PG8_STAGE(PG8_SA(0, 1), cA + hstep, voffA);
        if (wr == 1) PG8_BAR;
        PG8_WAIT_V(4); PG8_BAR;
        PG8_STAGE(PG8_SB(1, 0), cB + kstep, voffB); PG8_STAGE(PG8_SA(1, 0), cA + kstep, voffA); PG8_STAGE(PG8_SB(1, 1), cB + hstep + kstep, voffB);
        PG8_WAIT_V(6); PG8_BAR;
    }
    for (;;) {
        const bool has_next = S.next(ui + 1, nxt);
        const char* nA = has_next ? (const char*)g.A + (size_t)(nxt.pm & 4095) * tstep + (size_t)S.k0_of(nxt) * kstep : cA; const char* nB = has_next ? (const char*)g.Bt + (size_t)nxt.pn * tstep + (size_t)S.k0_of(nxt) * kstep : cB;
        const int nt = S.nt_of(cur);
        for (int t = 0; t < nt; t += 2) {
            const bool last = (t == nt - 2);
            const char* a1 = cA + (size_t)(t + 1) * kstep;
            const char* a2 = last ? nA : cA + (size_t)(t + 2) * kstep; const char* b2 = last ? nB : cB + (size_t)(t + 2) * kstep;
            const char* a3 = a2 + kstep; const char* b3 = b2 + kstep;
            if (last && has_next) S.a_ready(nxt);
            if constexpr (SP2) {
            PG8_LDB(B0, 0, 0); PG8_LDB(B1, 0, 1); PG8_SCHED; PG8_LDA(At, 0, 0); PG8_STAGE(PG8_SA(1, 1), a1 + hstep, voffA);
            PG8_WAIT_V(8); PG8_WAIT_L(0); PG8_BAR; PG8_MMA(0, 0, At, B0); PG8_MMA(0, 1, At, B1); PG8_BAR; PG8_SCHED;
            PG8_LDA(At, 0, 1); PG8_STAGE(PG8_SB(0, 0), b2, voffB); PG8_STAGE(PG8_SB(0, 1), b2 + hstep, voffB); PG8_STAGE(PG8_SA(0, 0), a2, voffA);
            PG8_WAIT_V(8); PG8_WAIT_L(0); PG8_BAR; PG8_MMA(1, 0, At, B0); PG8_MMA(1, 1, At, B1); PG8_BAR; PG8_SCHED;
            PG8_LDB(B0, 1, 0); PG8_LDB(B1, 1, 1); PG8_SCHED; PG8_LDA(At, 1, 0); PG8_STAGE(PG8_SA(0, 1), a2 + hstep, voffA);
            PG8_WAIT_V(8); PG8_WAIT_L(0); PG8_BAR; PG8_MMA(0, 0, At, B0); PG8_MMA(0, 1, At, B1); PG8_BAR; PG8_SCHED;
            PG8_LDA(At, 1, 1); PG8_STAGE(PG8_SB(1, 0), b3, voffB); PG8_STAGE(PG8_SB(1, 1), b3 + hstep, voffB); PG8_STAGE(PG8_SA(1, 0), a3, voffA);
            PG8_WAIT_V(8); PG8_WAIT_L(0); PG8_BAR; PG8_MMA(1, 0, At, B0); PG8_MMA(1, 1, At, B1); PG8_BAR; PG8_SCHED;
            } else {
            PG8_LDB(B0, 0, 0); PG8_SCHED; PG8_LDA(At, 0, 0); PG8_STAGE(PG8_SA(1, 1), a1 + hstep, voffA);
            PG8_WAIT_L(8); PG8_BAR; PG8_WAIT_L(0); PG8_MMA(0, 0, At, B0); PG8_BAR; PG8_SCHED;
            PG8_LDB(B1, 0, 1); PG8_STAGE(PG8_SB(0, 0), b2, voffB);
            PG8_BAR; PG8_WAIT_L(0); PG8_MMA(0, 1, At, B1); PG8_BAR;
            PG8_LDA(At, 0, 1); PG8_STAGE(PG8_SA(0, 0), a2, voffA);
            PG8_BAR; PG8_WAIT_L(0); PG8_MMA(1, 0, At, B0); PG8_BAR; PG8_SCHED;
            PG8_STAGE(PG8_SB(0, 1), b2 + hstep, voffB);
            PG8_WAIT_V(6); PG8_BAR; PG8_MMA(1, 1, At, B1); PG8_BAR;
            PG8_LDB(B0, 1, 0); PG8_SCHED; PG8_LDA(At, 1, 0); PG8_STAGE(PG8_SA(0, 1), a2 + hstep, voffA);
            PG8_WAIT_L(8); PG8_BAR; PG8_WAIT_L(0); PG8_MMA(0, 0, At, B0); PG8_BAR; PG8_SCHED;
            PG8_LDB(B1, 1, 1); PG8_STAGE(PG8_SB(1, 0), b3, voffB);
            PG8_BAR; PG8_WAIT_L(0); PG8_MMA(0, 1, At, B1); PG8_BAR;
            PG8_LDA(At, 1, 1); PG8_STAGE(PG8_SA(1, 0), a3, voffA);
            PG8_BAR; PG8_WAIT_L(0); PG8_MMA(1, 0, At, B0); PG8_BAR; PG8_SCHED;
            PG8_STAGE(PG8_SB(1, 1), b3 + hstep, voffB);
            PG8_WAIT_V(6); PG8_BAR; PG8_MMA(1, 1, At, B1); PG8_BAR;
            }
        }
        if constexpr (ALIGN_EPI) { if (wr == 0) PG8_BAR; }
        if constexpr (!Epi::AFTER_DRAIN) { E(acc, cur, wr, wc, fr, fq); S.done(cur); }
        if (!has_next) break;
#pragma unroll
        for (int a = 0; a < 2; ++a)
#pragma unroll
            for (int b = 0; b < 2; ++b)
#pragma unroll
                for (int m = 0; m < 4; ++m)
#pragma unroll
                    for (int n = 0; n < 2; ++n) acc[a][b][m][n] = (f32x4){0.f, 0.f, 0.f, 0.f};
        cur = nxt; cA = nA; cB = nB; ++ui;
        if constexpr (ALIGN_EPI) { if (wr == 1) PG8_BAR; }
    }
    PG8_WAIT_V(0);
    if constexpr (!ALIGN_EPI) { if (wr == 0) PG8_BAR; }
    PG8_BAR;
    if constexpr (Epi::AFTER_DRAIN) { E.fused(acc, cur, wr, wc, fr, fq, lds, wid, lane); S.done(cur); }
#undef PG8_SA
#undef PG8_SB
#undef PG8_STAGE
#undef PG8_LDA
#undef PG8_LDB
#undef PG8_MMA
#undef PG8_WAIT_V
#undef PG8_WAIT_L
#undef PG8_BAR
#undef PG8_SCHED
}
}

#define LAS __attribute__((address_space(3)))
typedef unsigned short bf16;
typedef float f32x4 __attribute__((ext_vector_type(4)));
typedef float f32x2 __attribute__((ext_vector_type(2)));
typedef float f32x16 __attribute__((ext_vector_type(16)));
typedef short bf16x8 __attribute__((ext_vector_type(8)));
typedef short s16x4 __attribute__((ext_vector_type(4)));
typedef unsigned u32x4 __attribute__((ext_vector_type(4)));
typedef unsigned u32x2 __attribute__((ext_vector_type(2)));
constexpr int NT = 512, NWAVES = 8;
__device__ __forceinline__ int tidx_from(int wv) { int l; asm volatile("v_mbcnt_lo_u32_b32 %0, -1, 0\n\tv_mbcnt_hi_u32_b32 %0, -1, %0" : "=v"(l)); return (wv << 6) | l; }
#define TIDX() tidx_from(wave_s_)
__device__ __forceinline__ int BIDX() { int v = blockIdx.x; asm volatile("" : "+s"(v)); return v; }
__device__ __forceinline__ int GDIM() { int v = gridDim.x; asm volatile("" : "+s"(v)); return v; }
constexpr int LDS_BYTES = 147456;

struct Args { const float* in[28]; float* out; unsigned char* ws; };
typedef const __attribute__((address_space(4))) Args* ArgsP;
__device__ __forceinline__ ArgsP get_args() { ArgsP p = (ArgsP)__builtin_amdgcn_kernarg_segment_ptr(); asm volatile("" : "+s"(p)); return p; }

__device__ __forceinline__ unsigned f2bf(float f) { unsigned u = __builtin_bit_cast(unsigned, f); return (u + 0x7fffu + ((u >> 16) & 1u)) >> 16; }
__device__ __forceinline__ unsigned pk2(float lo, float hi) { return pg8::cvt_pk_bf16(lo, hi); }
typedef float f32x2_t __attribute__((ext_vector_type(2))); typedef __bf16 bf16x2_t __attribute__((ext_vector_type(2)));
__device__ __forceinline__ unsigned pk2c(float lo, float hi) { f32x2_t v = {lo, hi}; bf16x2_t b = __builtin_convertvector(v, bf16x2_t); return __builtin_bit_cast(unsigned, b); }
__device__ __forceinline__ float max3f(float a, float b, float c) { float r; asm("v_max3_f32 %0, %1, %2, %3" : "=v"(r) : "v"(a), "v"(b), "v"(c)); return r; }
__device__ __forceinline__ float shx(float v, int lane, int o) { return __builtin_bit_cast(float, __builtin_amdgcn_ds_bpermute((lane ^ o) << 2, __builtin_bit_cast(int, v))); }
__device__ __forceinline__ float dpp_add(float v, float src_, const int ctrl, const int row_mask) { return v; }
__device__ __forceinline__ float wave_sum(float v, int lane) {
    (void)lane;
#define WS_DPP(ctrl_, rmask_) v += __builtin_bit_cast(float, __builtin_amdgcn_update_dpp(0, __builtin_bit_cast(int, v), ctrl_, rmask_, 0xF, false))
    WS_DPP(0xB1, 0xF);
    WS_DPP(0x4E, 0xF);
    WS_DPP(0x141, 0xF);
    WS_DPP(0x140, 0xF);
    WS_DPP(0x142, 0xA);
    WS_DPP(0x143, 0xC);
#undef WS_DPP
    return __builtin_bit_cast(float, __builtin_amdgcn_readlane(__builtin_bit_cast(int, v), 63));
}

__device__ __forceinline__ void transpose_item(const float* W, int K, int N, bf16* WT, int k0, int n0, int drow0, LAS float* scr, int lane) {
    float wv[32];
#pragma unroll
    for (int i = 0; i < 32; ++i) wv[i] = W[(size_t)(k0 + 2 * i + (lane >> 5)) * N + n0 + (lane & 31)];
#pragma unroll
    for (int i = 0; i < 32; ++i) scr[(2 * i + (lane >> 5)) * 33 + (lane & 31)] = wv[i];
    asm volatile("s_waitcnt lgkmcnt(0)" ::: "memory");
    const int c = lane & 7;
#pragma unroll
    for (int j = 0; j < 4; ++j) { const int n = (lane >> 3) + 8 * j; const LAS float* s = scr + (8 * c) * 33 + n;
        u32x4 o; o.x = pk2(s[0 * 33], s[1 * 33]); o.y = pk2(s[2 * 33], s[3 * 33]); o.z = pk2(s[4 * 33], s[5 * 33]); o.w = pk2(s[6 * 33], s[7 * 33]);
        *(u32x4*)(WT + (size_t)(drow0 + n) * K + k0 + 8 * c) = o; }
    asm volatile("s_waitcnt lgkmcnt(0)" ::: "memory");
}

__device__ __forceinline__ bool transpose_job(int& it, const float* W, int K, int N, bf16* WT, int mode, LAS float* scr, int lane) {
    const int nblk = N / 32, items = (K / 64) * nblk;
    if (it >= items) { it -= items; return false; }
    const int kb = it / nblk, nb = it % nblk, n0 = 32 * nb;
    const int drow0 = mode == 0 ? n0 : (256 * (n0 >> 7) + (n0 & 127) + (mode == 2 ? 128 : 0));
    transpose_item(W, K, N, WT, 64 * kb, n0, drow0, scr, lane);
    return true;
}

__device__ __forceinline__ void cvt_rows(const float* src, bf16* dst, int nb, int L, int W, int base, int Lp, int gtid, int gthreads) {
    const int w4 = W / 4, total = nb * L * w4;
    for (int i = gtid; i < total; i += gthreads) {
        const int c4 = i % w4, rj = i / w4, j = rj % L, b = rj / L;
        const f32x4 v = *(const f32x4*)(src + (size_t)i * 4);
        u32x2 o; o.x = pk2(v[0], v[1]); o.y = pk2(v[2], v[3]);
        *(u32x2*)(dst + (size_t)(base + b * Lp + j) * W + c4 * 4) = o;
    }
}

__device__ __forceinline__ void zero16(void* p_, int n16, int gtid, int gthreads) { unsigned z = 0u; asm volatile("" : "+v"(z)); for (int i = gtid; i < n16; i += gthreads) ((u32x4*)p_)[i] = (u32x4){z, z, z, z}; }
__device__ __forceinline__ int t5_bucket(int rel) {
    const int ret = rel > 0 ? 16 : 0; const int n = rel < 0 ? -rel : rel;
    if (n < 8) return ret + n;
    int j = 0; const long long n2 = (long long)n * n;
    while (j < 20 && (64ll << (j + 1)) <= n2) ++j;
    int large = 8 + j; if (large > 15) large = 15;
    return ret + large;
}

__device__ __forceinline__ void prologue(ArgsP a, LAS unsigned char* lds, int wave_s_) {
    const int tid = TIDX(), lane = tid & 63, wave = tid >> 6;
    unsigned char* ws = a->ws;
    const int G = GDIM(), gw = BIDX() * NWAVES + wave, NGW = G * NWAVES, gtid = BIDX() * NT + tid, gthreads = G * NT;
    {
        LAS float* sc = (LAS float*)lds;
        LAS float* red = (LAS float*)(lds + NSEQ * 1024 * 4);
        for (int i = tid; i < NSEQ * 1024; i += NT) { const int ci = i >> 10, k = i & 1023; const float c = ci < 2 ? a->in[2][ci * 1024 + k] : a->in[3][(ci - 2) * 1024 + k]; sc[i] = c / (1.0f + __expf(-c)); }
        __syncthreads();
        float* MODS = (float*)(ws + WS_MODS);
        const int col = tid & 63, kg = tid >> 6;
        for (int item = BIDX(); item < 2 * (NMOD / 64); item += G) {
            const int l = item / (NMOD / 64), n = (item % (NMOD / 64)) * 64 + col;
            const float* wp = a->in[10] + (size_t)l * 1024 * NMOD + (size_t)(kg * 128) * NMOD + n;
            float acc[NSEQ];
#pragma unroll
            for (int ci = 0; ci < NSEQ; ++ci) acc[ci] = 0.f;
            for (int k8 = 0; k8 < 128; k8 += 16) { float w[16];
#pragma unroll
                for (int u = 0; u < 16; ++u) w[u] = wp[(size_t)(k8 + u) * NMOD];
#pragma unroll
                for (int u = 0; u < 16; ++u)
#pragma unroll
                    for (int ci = 0; ci < NSEQ; ++ci) acc[ci] += sc[ci * 1024 + kg * 128 + k8 + u] * w[u]; }
#pragma unroll
            for (int ci = 0; ci < NSEQ; ++ci) red[(kg * NSEQ + ci) * 64 + col] = acc[ci];
            __syncthreads();
            for (int i = tid; i < NSEQ * 64; i += NT) { const int ci = i >> 6, cc = i & 63; float s = 0.f;
#pragma unroll
                for (int g = 0; g < 8; ++g) s += red[(g * NSEQ + ci) * 64 + cc];
                const int nn = (item % (NMOD / 64)) * 64 + cc; MODS[((size_t)l * NSEQ + ci) * NMOD + nn] = s + a->in[11][l * NMOD + nn]; }
            __syncthreads();
        }
    }
    __syncthreads();
    {
        LAS float* scr = (LAS float*)(lds + wave * 16384);
        constexpr int I_GU = (1024 / 64) * (DFF / 32), I_D = (DFF / 64) * (1024 / 32);
        constexpr int NITEMS = 8 * I_GU + 4 * I_D + 16 * 72 + 16 * 32 + 16 * 21 + 6 * 48 + 4 * 64 + 16 * 32;
        for (int it0 = gw; it0 < NITEMS; it0 += NGW) {
            int it = it0; bool done = false;
            for (int lj = 0; lj < 4 && !done; ++lj) {
                done = transpose_job(it, a->in[14] + (size_t)lj * 1024 * DFF, 1024, DFF, (bf16*)(ws + WS_WGU + lj * SZ_WGU), 1, scr, lane);
                if (!done) done = transpose_job(it, a->in[15] + (size_t)lj * 1024 * DFF, 1024, DFF, (bf16*)(ws + WS_WGU + lj * SZ_WGU), 2, scr, lane);
                if (!done) done = transpose_job(it, a->in[16] + (size_t)lj * DFF * 1024, DFF, 1024, (bf16*)(ws + WS_WD + lj * SZ_WD), 0, scr, lane);
            }
            if (!done) done = transpose_job(it, a->in[17], 1024, 2304, (bf16*)(ws + WS_WAB), 0, scr, lane);
            if (!done) done = transpose_job(it, a->in[18], 1024, 1024, (bf16*)(ws + WS_WOAB), 0, scr, lane);
            if (!done) done = transpose_job(it, a->in[22], 1024, 672, (bf16*)(ws + WS_WCIN), 0, scr, lane);
            if (!done) done = transpose_job(it, a->in[25], 384, 1536, (bf16*)(ws + WS_WQB), 0, scr, lane);
            if (!done) done = transpose_job(it, a->in[26], 256, 2048, (bf16*)(ws + WS_WKVB), 0, scr, lane);
            if (!done) done = transpose_job(it, a->in[27], 1024, 1024, (bf16*)(ws + WS_WOC), 0, scr, lane);
        }
        zero16(ws + WS_WCIN + (size_t)672 * 1024 * 2, 96 * 1024 * 2 / 16, gtid, gthreads);
    }
    {
        float* rope = (float*)(ws + WS_ROPE);
        for (int i = gtid; i < SEQ * 16; i += gthreads) { const int pos = i >> 4, k = i & 15;
            const float inv = (float)pow(10000.0, -(double)k / 16.0); const float ang = (float)pos * inv;
            rope[pos * 32 + k] = (float)cos((double)ang); rope[pos * 32 + 16 + k] = (float)sin((double)ang); }
        float* lutA = (float*)(ws + WS_LUTA); float* lutB = (float*)(ws + WS_LUTB);
        for (int i = gtid; i < 8 * LUTN; i += gthreads) { const int h = i / LUTN, rel = (i % LUTN) - LUT0;
            const int cl = rel < -128 ? -128 : (rel > 128 ? 128 : rel);
            lutA[i] = a->in[19][(cl + 128) * 8 + h] * LOG2E;
            lutB[i] = a->in[20][t5_bucket(rel) * 8 + h] * LOG2E; }
    }
}
__device__ __forceinline__ void prologue_l1(ArgsP a, int wave_s_) {
    const int gtid = BIDX() * NT + TIDX(), gthreads = GDIM() * NT;
    cvt_rows(a->in[8], (bf16*)(a->ws + WS_KVN), 16, PAST, 256, NPROMPT, PAST + 32, gtid, gthreads);
    cvt_rows(a->in[9], (bf16*)(a->ws + WS_KR), 16, PAST, 32, NPROMPT, PAST + 32, gtid, gthreads);
    zero16(a->ws + WS_KR + (size_t)RKV * 32 * 2, 64 * 32 * 2 / 16, gtid, gthreads);
}

__device__ __forceinline__ void norm_mod_phase(ArgsP a, bool from_input, const float* g, const float* modsL, int ishift, int iscale, int nparts, int wave_s_) {
    const int lane = TIDX() & 63, gw = BIDX() * NWAVES + (TIDX() >> 6), NGW = GDIM() * NWAVES;
    float* X = a->out; bf16* H = (bf16*)(a->ws + WS_H);
    const float* xin0 = a->in[0]; const float* xin1 = a->in[1];
    f32x4 gv[4];
#pragma unroll
    for (int j = 0; j < 4; ++j) gv[j] = *(const f32x4*)(g + 4 * lane + 256 * j);
#define NM_ROWPTR(r_) ((from_input ? ((r_) < NPROMPT ? xin0 + (size_t)(r_) * DM : xin1 + (size_t)((r_) - NPROMPT) * DM) : X + (size_t)(r_) * DM) + 4 * lane)
    f32x4 v[4];
    if (gw < R) { const float* xr = NM_ROWPTR(gw);
#pragma unroll
        for (int j = 0; j < 4; ++j) v[j] = *(const f32x4*)(xr + 256 * j); }
    for (int row = gw; row < R; row += NGW) {
        const int nrow = row + NGW; f32x4 vn[4];
        if (nrow < R) { const float* xr = NM_ROWPTR(nrow);
#pragma unroll
            for (int j = 0; j < 4; ++j) vn[j] = *(const f32x4*)(xr + 256 * j); }
        if (row >= NPROMPT && nparts > 0) {
            int l2 = lane; asm volatile("" : "+v"(l2));
            const float* pp = (const float*)(a->ws + WS_PART) + (size_t)(row - NPROMPT) * DM + 4 * l2;
            for (int s = 0; s < nparts; ++s)
#pragma unroll
                for (int j = 0; j < 4; ++j) v[j] = v[j] + *(const f32x4*)(pp + (size_t)s * NSAMP * DM + 256 * j);
        }
        float ss = 0.f;
#pragma unroll
        for (int j = 0; j < 4; ++j) ss += (v[j][0] * v[j][0] + v[j][1] * v[j][1]) + (v[j][2] * v[j][2] + v[j][3] * v[j][3]);
        if ((from_input && row >= NPROMPT) || (row >= NPROMPT && nparts > 0)) {
#pragma unroll
            for (int j = 0; j < 4; ++j) *(f32x4*)(X + (size_t)row * DM + 4 * lane + 256 * j) = v[j];
        }
        f32x4 shv[4], scv[4];
        {   const float* mp = modsL + (size_t)pg8::cidx_of(row) * NMOD + 4 * lane;
#pragma unroll
            for (int j = 0; j < 4; ++j) { shv[j] = *(const f32x4*)(mp + ishift * DM + 256 * j); scv[j] = *(const f32x4*)(mp + iscale * DM + 256 * j); } }
        const float rs = 1.0f / sqrtf(wave_sum(ss, lane) * (1.0f / DM) + EPS);
#pragma unroll
        for (int j = 0; j < 4; ++j) { const f32x4 sh = shv[j], sc = scv[j];
            const f32x4 h = (v[j] * rs) * gv[j] * (sc + 1.0f) + sh;
            u32x2 o; o.x = pk2(h[0], h[1]); o.y = pk2(h[2], h[3]);
            *(u32x2*)(H + (size_t)row * DM + 4 * lane + 256 * j) = o; }
#pragma unroll
        for (int j = 0; j < 4; ++j) v[j] = vn[j];
    }
#undef NM_ROWPTR
}
__device__ __forceinline__ void final_norm_phase(ArgsP a, int wave_s_) {
    const int lane = TIDX() & 63, gw = BIDX() * NWAVES + (TIDX() >> 6), NGW = GDIM() * NWAVES;
    const float* g = a->in[13]; f32x4 gv[4];
#pragma unroll
    for (int j = 0; j < 4; ++j) gv[j] = *(const f32x4*)(g + 4 * lane + 256 * j);
    f32x4 v[4];
    if (gw < R) {
#pragma unroll
        for (int j = 0; j < 4; ++j) v[j] = *(const f32x4*)(a->out + (size_t)gw * DM + 4 * lane + 256 * j); }
    for (int row = gw; row < R; row += NGW) {
        float* xr = a->out + (size_t)row * DM; const int nrow = row + NGW; f32x4 vn[4];
        if (nrow < R) {
#pragma unroll
            for (int j = 0; j < 4; ++j) vn[j] = *(const f32x4*)(a->out + (size_t)nrow * DM + 4 * lane + 256 * j); }
        if (row >= NPROMPT) { int l2 = lane; asm volatile("" : "+v"(l2)); const float* pp = (const float*)(a->ws + WS_PART) + (size_t)(row - NPROMPT) * DM + 4 * l2;
            for (int s = 0; s < 11; ++s)
#pragma unroll
                for (int j = 0; j < 4; ++j) v[j] = v[j] + *(const f32x4*)(pp + (size_t)s * NSAMP * DM + 256 * j); }
        float ss = 0.f;
#pragma unroll
        for (int j = 0; j < 4; ++j) ss += (v[j][0] * v[j][0] + v[j][1] * v[j][1]) + (v[j][2] * v[j][2] + v[j][3] * v[j][3]);
        const float rs = 1.0f / sqrtf(wave_sum(ss, lane) * (1.0f / DM) + EPS);
#pragma unroll
        for (int j = 0; j < 4; ++j) *(f32x4*)(xr + 4 * lane + 256 * j) = (v[j] * rs) * gv[j];
#pragma unroll
        for (int j = 0; j < 4; ++j) v[j] = vn[j];
    }
}
__device__ __forceinline__ void mla_norm_phase(ArgsP a, int wave_s_) {
    const int lane = TIDX() & 63, gw = BIDX() * NWAVES + (TIDX() >> 6), NGW = GDIM() * NWAVES;
    const float* CIN = (const float*)(a->ws + WS_CIN); const float* rope = (const float*)(a->ws + WS_ROPE);
    bf16* QN = (bf16*)(a->ws + WS_QN); bf16* KVN = (bf16*)(a->ws + WS_KVN); bf16* KR = (bf16*)(a->ws + WS_KR);
    const float* qg = a->in[23]; const float* kg = a->in[24];
    f32x2 qgv[3];
#pragma unroll
    for (int j = 0; j < 3; ++j) qgv[j] = *(const f32x2*)(qg + 2 * lane + 128 * j);
    const f32x4 kgv = *(const f32x4*)(kg + 4 * lane);
    f32x2 q[3]; f32x4 kv; float kr1 = 0.f, kr2 = 0.f;
#define MN_LOAD(qd_, kvd_, k1_, k2_, r_) do { if ((r_) < R) { const float* c_ = CIN + (size_t)(r_) * 768; _Pragma("unroll") for (int j = 0; j < 3; ++j) qd_[j] = *(const f32x2*)(c_ + 2 * lane + 128 * j); \
        kvd_ = *(const f32x4*)(c_ + 384 + 4 * lane); if (lane < 16) { k1_ = c_[640 + lane]; k2_ = c_[656 + lane]; } } } while (0)
    MN_LOAD(q, kv, kr1, kr2, gw);
    for (int row = gw; row < R; row += NGW) {
        f32x2 qn[3]; f32x4 kvn; float kn1 = 0.f, kn2 = 0.f;
        MN_LOAD(qn, kvn, kn1, kn2, row + NGW);
        const bool isp = row < NPROMPT; const int rs = row - NPROMPT, b = rs >> 5, t = rs & 31;
        const int kvrow = isp ? row : NPROMPT + b * (PAST + 32) + PAST + t; const int pos = isp ? (row & (SEQ - 1)) : PAST + t;
        float cs_ = 0.f, sn_ = 0.f; if (lane < 16) { cs_ = rope[(size_t)pos * 32 + lane]; sn_ = rope[(size_t)pos * 32 + 16 + lane]; }
        float ss = 0.f;
#pragma unroll
        for (int j = 0; j < 3; ++j) ss += q[j][0] * q[j][0] + q[j][1] * q[j][1];
        float s2 = (kv[0] * kv[0] + kv[1] * kv[1]) + (kv[2] * kv[2] + kv[3] * kv[3]);
        const float rq = 1.0f / sqrtf(wave_sum(ss, lane) * (1.0f / 384.0f) + EPS), rk = 1.0f / sqrtf(wave_sum(s2, lane) * (1.0f / 256.0f) + EPS);
#pragma unroll
        for (int j = 0; j < 3; ++j) { const f32x2 o = (q[j] * rq) * qgv[j]; *(unsigned*)(QN + (size_t)row * 384 + 2 * lane + 128 * j) = pk2(o[0], o[1]); }
        const f32x4 ko = (kv * rk) * kgv;
        float* okv = a->out + (isp ? O_CKVP + (size_t)row * 256 : O_CKVS + (size_t)rs * 256) + 4 * lane; *(f32x4*)okv = ko;
        u32x2 kw; kw.x = pk2(ko[0], ko[1]); kw.y = pk2(ko[2], ko[3]); *(u32x2*)(KVN + (size_t)kvrow * 256 + 4 * lane) = kw;
        if (lane < 16) {
            const float x1 = kr1, x2 = kr2, cs = cs_, sn = sn_;
            const float o1 = x1 * cs - x2 * sn, o2 = x1 * sn + x2 * cs;
            float* okr = a->out + (isp ? O_CKRP + (size_t)row * 32 : O_CKRS + (size_t)rs * 32);
            okr[lane] = o1; okr[16 + lane] = o2;
            KR[(size_t)kvrow * 32 + lane] = (bf16)f2bf(o1); KR[(size_t)kvrow * 32 + 16 + lane] = (bf16)f2bf(o2);
        }
#pragma unroll
        for (int j = 0; j < 3; ++j) q[j] = qn[j];
        kv = kvn; kr1 = kn1; kr2 = kn2;
    }
#undef MN_LOAD
}

struct AttnItem {
    const bf16* Q; int q_stride;
    const bf16* K; int k_stride;
    const bf16* K2;
    const float* rope;
    const bf16* V; int v_stride;
    bf16* O;
    int q_row0, nq_valid, k_row0, q_kidx0;
    int t_lo, t_hi, wlo0, whi0, wstep_lo, wstep, nkeys;
    const float* lut;
    float m0, l0, scale2;
};
constexpr int KSTR = 104, VROW = 72;
constexpr int KBUF = 64 * KSTR * 2, VBUF = 64 * VROW * 2;
constexpr int ATT_LUT_OFF = 2 * (KBUF + VBUF);
typedef short v4i16_t __attribute__((ext_vector_type(4)));
__device__ __forceinline__ int crow(int i, int hi) { return (i & 3) + 8 * (i >> 2) + 4 * hi; }
__device__ __forceinline__ s16x4 vtr(const LAS unsigned char* p) { return __builtin_bit_cast(s16x4, __builtin_amdgcn_ds_read_tr16_b64_v4i16((LAS v4i16_t*)p)); }
__device__ __forceinline__ float xhalf(float v, int hi) { auto r = __builtin_amdgcn_permlane32_swap(__builtin_bit_cast(unsigned, v), __builtin_bit_cast(unsigned, v), false, false); return __builtin_bit_cast(float, hi ? r[0] : r[1]); }
__device__ __forceinline__ float swapmax(float v, int hi) { return fmaxf(v, xhalf(v, hi)); }
__device__ __forceinline__ float swapsum(float v, int hi) { return v + xhalf(v, hi); }
__device__ __forceinline__ float bf2f(short b) { return __builtin_bit_cast(float, (unsigned)(unsigned short)b << 16); }
#define MFMA32(a, b, c) __builtin_amdgcn_mfma_f32_32x32x16_bf16((a), (b), (c), 0, 0, 0)
constexpr float RESCALE_THR = 8.0f;

template <int DQ, bool BIAS, bool TAIL>
__device__ __forceinline__ void attn_item(const AttnItem& A, LAS unsigned char* lds, int wave_s_) {
    constexpr int NKK = DQ / 16;
    const int tid = TIDX(), lane = tid & 63, w = __builtin_amdgcn_readfirstlane(tid >> 6), r32 = lane & 31, hi = lane >> 5;
    LAS float* lut = (LAS float*)(lds + ATT_LUT_OFF);
    __syncthreads();
    if (BIAS) { for (int i = tid; i < LUTN; i += NT) lut[i] = A.lut[i]; }
    const int wlo = max(A.wlo0 + w * A.wstep_lo, A.t_lo), whi = min(A.whi0 + w * A.wstep, A.t_hi);
    const int qrow = A.q_row0 + 64 * w;
    bf16x8 qf[2][NKK];
#pragma unroll
    for (int qb = 0; qb < 2; ++qb) {
        const int row = (wlo <= whi ? qrow : A.q_row0) + 32 * qb + r32;
        float qv[NKK][8];
#pragma unroll
        for (int kk = 0; kk < NKK; ++kk) { const bf16x8 raw = *(const bf16x8*)(A.Q + (size_t)row * A.q_stride + 16 * kk + 8 * hi);
#pragma unroll
            for (int j = 0; j < 8; ++j) qv[kk][j] = bf2f(raw[j]); }
        if (DQ == 96) {
            const int pos = row < NPROMPT ? (row & (SEQ - 1)) : PAST + ((row - NPROMPT) & 31);
            const float* rp = A.rope + (size_t)pos * 32 + 8 * hi;
            const f32x4 c0 = *(const f32x4*)rp, c1 = *(const f32x4*)(rp + 4), s0 = *(const f32x4*)(rp + 16), s1 = *(const f32x4*)(rp + 20);
#pragma unroll
            for (int j = 0; j < 8; ++j) { const float x1 = qv[NKK - 2][j], x2 = qv[NKK - 1][j], c = j < 4 ? c0[j & 3] : c1[j & 3], s = j < 4 ? s0[j & 3] : s1[j & 3];
                qv[NKK - 2][j] = x1 * c - x2 * s; qv[NKK - 1][j] = x1 * s + x2 * c; }
        }
#pragma unroll
        for (int kk = 0; kk < NKK; ++kk) { u32x4 wq;
#pragma unroll
            for (int jp = 0; jp < 4; ++jp) wq[jp] = pk2(qv[kk][2 * jp] * A.scale2, qv[kk][2 * jp + 1] * A.scale2);
            qf[qb][kk] = __builtin_bit_cast(bf16x8, wq); }
    }
    f32x16 o[2][2];
    float zinit = 0.f; asm volatile("" : "+v"(zinit));
    const f32x16 zero16v = {0.f, 0.f, 0.f, 0.f, 0.f, 0.f, 0.f, 0.f, 0.f, 0.f, 0.f, 0.f, 0.f, 0.f, 0.f, 0.f};
    float mref[2] = {A.m0, A.m0};
#pragma unroll
    for (int qb = 0; qb < 2; ++qb)
#pragma unroll
        for (int i = 0; i < 16; ++i) { o[0][qb][i] = zinit; o[1][qb][i] = zinit; }
    float lrun[2] = {hi == 0 ? A.l0 : 0.f, hi == 0 ? A.l0 : 0.f};
    bool first = A.l0 == 0.f;
    const int lkey = tid >> 3, lpc = tid & 7, l2key = tid >> 2, l2pc = tid & 3;
    u32x4 kreg, k2reg, vreg;
#define ATT_GLOAD(t_) do { const size_t row_ = (size_t)(A.k_row0 + 64 * (t_)); \
        kreg = *(const u32x4*)(A.K + (row_ + lkey) * A.k_stride + 8 * lpc); vreg = *(const u32x4*)(A.V + (row_ + lkey) * A.v_stride + 8 * lpc); \
        if (DQ == 96 && tid < 256) k2reg = *(const u32x4*)(A.K2 + (row_ + l2key) * 32 + 8 * l2pc); } while (0)
#define ATT_LSTORE(buf_) do { LAS unsigned char* kb_ = lds + (buf_) * KBUF; LAS unsigned char* vb_ = lds + 2 * KBUF + (buf_) * VBUF; \
        *(LAS u32x4*)(kb_ + (lkey * KSTR + 8 * lpc) * 2) = kreg; *(LAS u32x4*)(vb_ + (lkey * VROW + 8 * lpc) * 2) = vreg; \
        if (DQ == 96 && tid < 256) *(LAS u32x4*)(kb_ + (l2key * KSTR + 64 + 8 * l2pc) * 2) = k2reg; } while (0)
    ATT_GLOAD(A.t_lo); ATT_LSTORE(0);
    __syncthreads();
    const int i16 = lane & 15, vlane_off = ((4 * hi + (i16 >> 2)) * VROW + 16 * ((lane >> 4) & 1) + 4 * (i16 & 3)) * 2;
    const int koff = (r32 * KSTR + 8 * hi) * 2;
    if (w < 4) __builtin_amdgcn_s_setprio(2);
    int buf = 0;
    for (int t = A.t_lo; t <= A.t_hi; ++t) {
        const bool more = t < A.t_hi;
        const bool act = t >= wlo && t <= whi;
        const LAS unsigned char* kb = lds + buf * KBUF + koff; const LAS unsigned char* vb = lds + 2 * KBUF + buf * VBUF + vlane_off;
        bf16x8 kf[NKK];
        if (act) {
#pragma unroll
            for (int kk = 0; kk < NKK; ++kk) kf[kk] = *(const LAS bf16x8*)(kb + (16 * kk) * 2);
        }
        if (more) ATT_GLOAD(t + 1);
        if (act) {
#pragma unroll
            for (int kbk = 0; kbk < 2; ++kbk) {
                __builtin_amdgcn_sched_barrier(0);
                f32x16 s[2];
                s[0] = MFMA32(kf[0], qf[0][0], zero16v); s[1] = MFMA32(kf[0], qf[1][0], zero16v);
#pragma unroll
                for (int kk = 1; kk < NKK; ++kk) { s[0] = MFMA32(kf[kk], qf[0][kk], s[0]); s[1] = MFMA32(kf[kk], qf[1][kk], s[1]); }
                s16x4 vlo[2][2], vhi[2][2];
#pragma unroll
                for (int st = 0; st < 2; ++st)
#pragma unroll
                    for (int d = 0; d < 2; ++d) { const LAS unsigned char* vp = vb + ((32 * kbk + 16 * st) * VROW + 32 * d) * 2; vlo[st][d] = vtr(vp); vhi[st][d] = vtr(vp + 8 * VROW * 2); }
                __builtin_amdgcn_sched_barrier(0);
                float mx[2];
#pragma unroll
                for (int qb = 0; qb < 2; ++qb) {
                    if (BIAS || TAIL) {
                        const int qk = A.q_kidx0 + 64 * w + 32 * qb + r32;
#pragma unroll
                        for (int i = 0; i < 16; ++i) { const int kidx = 64 * t + 32 * kbk + crow(i, hi);
                            float v = s[qb][i]; if (BIAS) v += lut[kidx - qk + LUT0]; if (TAIL && kidx >= A.nkeys) v = -1.0e30f; s[qb][i] = v; }
                    }
                    const float t0 = max3f(s[qb][0], s[qb][1], s[qb][2]), t1 = max3f(s[qb][3], s[qb][4], s[qb][5]), t2 = max3f(s[qb][6], s[qb][7], s[qb][8]),
                                t3 = max3f(s[qb][9], s[qb][10], s[qb][11]), t4 = max3f(s[qb][12], s[qb][13], s[qb][14]);
                    const float m = max3f(max3f(t0, t1, t2), max3f(t3, t4, s[qb][15]), t0);
                    mx[qb] = swapmax(m, hi) - mref[qb];
                }
                const bool need0 = first || mx[0] > RESCALE_THR, need1 = first || mx[1] > RESCALE_THR;
                if (__builtin_amdgcn_ballot_w64(need0 || need1) != 0ull) {
#pragma unroll
                    for (int qb = 0; qb < 2; ++qb) {
                        const float delta = (qb == 0 ? need0 : need1) ? mx[qb] : 0.f, alpha = __builtin_amdgcn_exp2f(-delta);
#pragma unroll
                        for (int i = 0; i < 16; ++i) { o[0][qb][i] *= alpha; o[1][qb][i] *= alpha; }
                        lrun[qb] *= alpha; mref[qb] += delta;
                    }
                    first = false;
                }
#pragma unroll
                for (int qb = 0; qb < 2; ++qb) { float l4[4] = {0.f, 0.f, 0.f, 0.f};
#pragma unroll
                    for (int i = 0; i < 16; ++i) { const float pv = __builtin_amdgcn_exp2f(s[qb][i] - mref[qb]); s[qb][i] = pv; l4[i & 3] += pv; }
                    lrun[qb] += (l4[0] + l4[1]) + (l4[2] + l4[3]); }
                bf16x8 pf[2][2];
#pragma unroll
                for (int st = 0; st < 2; ++st)
#pragma unroll
                    for (int qb = 0; qb < 2; ++qb) { u32x4 pw;
#pragma unroll
                        for (int j = 0; j < 4; ++j) pw[j] = pk2c(s[qb][8 * st + 2 * j], s[qb][8 * st + 2 * j + 1]);
                        pf[st][qb] = __builtin_bit_cast(bf16x8, pw); }
                if (kbk == 0) {
#pragma unroll
                    for (int kk = 0; kk < NKK; ++kk) kf[kk] = *(const LAS bf16x8*)(kb + (32 * KSTR + 16 * kk) * 2);
                }
                __builtin_amdgcn_sched_barrier(0);
#pragma unroll
                for (int st = 0; st < 2; ++st)
#pragma unroll
                    for (int d = 0; d < 2; ++d) {
                        const bf16x8 vf = __builtin_shufflevector(vlo[st][d], vhi[st][d], 0, 1, 2, 3, 4, 5, 6, 7);
                        o[d][0] = MFMA32(vf, pf[st][0], o[d][0]);
                        o[d][1] = MFMA32(vf, pf[st][1], o[d][1]);
                    }
            }
        }
        if (more) ATT_LSTORE(buf ^ 1);
        __syncthreads();
        buf ^= 1;
    }
#undef ATT_GLOAD
#undef ATT_LSTORE
    __builtin_amdgcn_s_setprio(0);
    if (wlo <= whi) {
#pragma unroll
        for (int qb = 0; qb < 2; ++qb) {
            const float inv = 1.0f / swapsum(lrun[qb], hi);
            const int qi = 32 * qb + r32;
            if (qi < A.nq_valid) {
                bf16* op = A.O + (size_t)(qrow + qi) * 1024;
#pragma unroll
                for (int d = 0; d < 2; ++d)
#pragma unroll
                    for (int g = 0; g < 4; ++g) { u32x2 wv; wv.x = pk2(o[d][qb][4 * g] * inv, o[d][qb][4 * g + 1] * inv); wv.y = pk2(o[d][qb][4 * g + 2] * inv, o[d][qb][4 * g + 3] * inv);
                        *(u32x2*)(op + 32 * d + 8 * g + 4 * hi) = wv; }
            }
        }
    }
}

constexpr int OKSTR = 104, OVSTR = 68;
constexpr int OKBUF = 64 * OKSTR * 2, OVBUF = 64 * OVSTR * 2;
constexpr int OATT_LUT_OFF = 2 * (OKBUF + OVBUF);

template <int DQ, bool BIAS>
__device__ __forceinline__ void attn_item_l0(const AttnItem& A, LAS unsigned char* lds, int wave_s_) {
    constexpr int NKK = DQ / 16;
    const int tid = TIDX(), lane = tid & 63, w = __builtin_amdgcn_readfirstlane(tid >> 6), r32 = lane & 31, hi = lane >> 5;
    LAS float* lut = (LAS float*)(lds + OATT_LUT_OFF);
    __syncthreads();
    if (BIAS) { for (int i = tid; i < LUTN; i += NT) lut[i] = A.lut[i]; }
    const int wlo = max(A.wlo0 + w * A.wstep_lo, A.t_lo), whi = min(A.whi0 + w * A.wstep, A.t_hi);
    const int qrow = A.q_row0 + 64 * w;
    bf16x8 qf[2][NKK];
#pragma unroll
    for (int qb = 0; qb < 2; ++qb)
#pragma unroll
        for (int kk = 0; kk < NKK; ++kk) qf[qb][kk] = *(const bf16x8*)(A.Q + (size_t)((wlo <= whi ? qrow : A.q_row0) + 32 * qb + r32) * A.q_stride + 16 * kk + 8 * hi);
    if (DQ == 96) {
#pragma unroll
        for (int qb = 0; qb < 2; ++qb) {
            const int row = (wlo <= whi ? qrow : A.q_row0) + 32 * qb + r32; const int pos = row < NPROMPT ? (row & (SEQ - 1)) : PAST + ((row - NPROMPT) & 31);
            const float* rp = A.rope + (size_t)pos * 32 + 8 * hi;
            const f32x4 c0 = *(const f32x4*)rp, c1 = *(const f32x4*)(rp + 4), s0 = *(const f32x4*)(rp + 16), s1 = *(const f32x4*)(rp + 20);
            u32x4 w1, w2;
#pragma unroll
            for (int jp = 0; jp < 4; ++jp) {
                float o1[2], o2[2];
#pragma unroll
                for (int e = 0; e < 2; ++e) { const int j = 2 * jp + e;
                    const float x1 = __builtin_bit_cast(float, (unsigned)(unsigned short)qf[qb][NKK - 2][j] << 16), x2 = __builtin_bit_cast(float, (unsigned)(unsigned short)qf[qb][NKK - 1][j] << 16);
                    const float c = j < 4 ? c0[j & 3] : c1[j & 3], s = j < 4 ? s0[j & 3] : s1[j & 3];
                    o1[e] = x1 * c - x2 * s; o2[e] = x1 * s + x2 * c; }
                w1[jp] = pk2(o1[0], o1[1]); w2[jp] = pk2(o2[0], o2[1]);
            }
            qf[qb][NKK - 2] = __builtin_bit_cast(bf16x8, w1); qf[qb][NKK - 1] = __builtin_bit_cast(bf16x8, w2);
        }
    }
    f32x16 o[2][2];
#pragma unroll
    for (int d = 0; d < 2; ++d)
#pragma unroll
        for (int qb = 0; qb < 2; ++qb)
#pragma unroll
            for (int i = 0; i < 16; ++i) o[d][qb][i] = 0.f;
    float mrun[2] = {A.m0, A.m0}, lrun[2] = {hi == 0 ? A.l0 : 0.f, hi == 0 ? A.l0 : 0.f};
    const int lkey = tid >> 3, lpc = tid & 7, l2key = tid >> 2, l2pc = tid & 3;
    u32x4 kreg, k2reg, vreg;
    auto gload = [&](int t) {
        const size_t row = (size_t)(A.k_row0 + 64 * t);
        kreg = *(const u32x4*)(A.K + (row + lkey) * A.k_stride + 8 * lpc);
        vreg = *(const u32x4*)(A.V + (row + lkey) * A.v_stride + 8 * lpc);
        if (DQ == 96 && tid < 256) k2reg = *(const u32x4*)(A.K2 + (row + l2key) * 32 + 8 * l2pc);
    };
    auto lstore = [&](int buf) {
        LAS unsigned char* kb = lds + buf * OKBUF; LAS unsigned char* vb = lds + 2 * OKBUF + buf * OVBUF;
        *(LAS u32x4*)(kb + (lkey * OKSTR + 8 * lpc) * 2) = kreg;
        if (DQ == 96 && tid < 256) *(LAS u32x4*)(kb + (l2key * OKSTR + 64 + 8 * l2pc) * 2) = k2reg;
        LAS unsigned short* vt = (LAS unsigned short*)vb + (8 * lpc) * OVSTR + lkey;
#pragma unroll
        for (int j = 0; j < 4; ++j) { const unsigned wv = vreg[j]; vt[(2 * j) * OVSTR] = (unsigned short)(wv & 0xffffu); vt[(2 * j + 1) * OVSTR] = (unsigned short)(wv >> 16); }
    };
    gload(A.t_lo); lstore(0);
    __syncthreads();
    int buf = 0;
    for (int t = A.t_lo; t <= A.t_hi; ++t) {
        const bool more = t < A.t_hi;
        if (more) gload(t + 1);
        if (t >= wlo && t <= whi) {
            LAS unsigned char* kb = lds + buf * OKBUF; LAS unsigned char* vb = lds + 2 * OKBUF + buf * OVBUF;
            f32x16 s[2][2];
            __builtin_amdgcn_s_setprio(1);
#pragma unroll
            for (int kbk = 0; kbk < 2; ++kbk) {
#pragma unroll
                for (int qb = 0; qb < 2; ++qb)
#pragma unroll
                    for (int i = 0; i < 16; ++i) s[kbk][qb][i] = 0.f;
#pragma unroll
                for (int kk = 0; kk < NKK; ++kk) {
                    const bf16x8 kf = *(const LAS bf16x8*)(kb + ((32 * kbk + r32) * OKSTR + 16 * kk + 8 * hi) * 2);
                    s[kbk][0] = MFMA32(kf, qf[0][kk], s[kbk][0]);
                    s[kbk][1] = MFMA32(kf, qf[1][kk], s[kbk][1]);
                }
            }
            __builtin_amdgcn_s_setprio(0);
#pragma unroll
            for (int qb = 0; qb < 2; ++qb) {
                const int qk = A.q_kidx0 + 64 * w + 32 * qb + r32;
                float mx = -3.0e38f;
#pragma unroll
                for (int kbk = 0; kbk < 2; ++kbk)
#pragma unroll
                    for (int i = 0; i < 16; ++i) {
                        const int kidx = 64 * t + 32 * kbk + crow(i, hi);
                        float v = s[kbk][qb][i] * A.scale2;
                        if (BIAS) v += lut[kidx - qk + LUT0];
                        if (kidx >= A.nkeys) v = -1.0e30f;
                        s[kbk][qb][i] = v; mx = fmaxf(mx, v);
                    }
                mx = fmaxf(mx, xhalf(mx, hi));
                const float mnew = fmaxf(mrun[qb], mx), alpha = __builtin_amdgcn_exp2f(mrun[qb] - mnew);
                mrun[qb] = mnew;
                float ls = 0.f;
#pragma unroll
                for (int kbk = 0; kbk < 2; ++kbk)
#pragma unroll
                    for (int i = 0; i < 16; ++i) { const float p = __builtin_amdgcn_exp2f(s[kbk][qb][i] - mnew); s[kbk][qb][i] = p; ls += p; }
                lrun[qb] = lrun[qb] * alpha + ls;
#pragma unroll
                for (int d = 0; d < 2; ++d)
#pragma unroll
                    for (int i = 0; i < 16; ++i) o[d][qb][i] *= alpha;
            }
            __builtin_amdgcn_s_setprio(1);
#pragma unroll
            for (int kbk = 0; kbk < 2; ++kbk)
#pragma unroll
                for (int st = 0; st < 2; ++st) {
                    bf16x8 pf[2];
#pragma unroll
                    for (int qb = 0; qb < 2; ++qb) { u32x4 pw;
#pragma unroll
                        for (int j = 0; j < 4; ++j) pw[j] = pk2c(s[kbk][qb][8 * st + 2 * j], s[kbk][qb][8 * st + 2 * j + 1]);
                        pf[qb] = __builtin_bit_cast(bf16x8, pw); }
#pragma unroll
                    for (int d = 0; d < 2; ++d) {
                        const LAS unsigned char* vp = vb + ((32 * d + r32) * OVSTR + 32 * kbk + 16 * st + 4 * hi) * 2;
                        const s16x4 lo4 = *(const LAS s16x4*)vp, hi4 = *(const LAS s16x4*)(vp + 16);
                        const bf16x8 vf = __builtin_shufflevector(lo4, hi4, 0, 1, 2, 3, 4, 5, 6, 7);
                        o[d][0] = MFMA32(vf, pf[0], o[d][0]);
                        o[d][1] = MFMA32(vf, pf[1], o[d][1]);
                    }
                }
        }
        __builtin_amdgcn_s_setprio(0);
        if (more) lstore(buf ^ 1);
        __syncthreads();
        buf ^= 1;
    }
    if (wlo <= whi) {
#pragma unroll
        for (int qb = 0; qb < 2; ++qb) {
            const float lt = lrun[qb] + xhalf(lrun[qb], hi); const float inv = 1.0f / lt;
            const int qi = 32 * qb + r32;
            if (qi < A.nq_valid) {
                bf16* op = A.O + (size_t)(qrow + qi) * 1024;
#pragma unroll
                for (int d = 0; d < 2; ++d)
#pragma unroll
                    for (int g = 0; g < 4; ++g) { u32x2 wv; wv.x = pk2(o[d][qb][4 * g] * inv, o[d][qb][4 * g + 1] * inv); wv.y = pk2(o[d][qb][4 * g + 2] * inv, o[d][qb][4 * g + 3] * inv);
                        *(u32x2*)(op + 32 * d + 8 * g + 4 * hi) = wv; }
            }
        }
    }
}


__device__ __forceinline__ void attn0_phase(ArgsP a, LAS unsigned char* lds, int wave_s_) {
    unsigned char* ws = a->ws;
    const bf16* Q0 = (const bf16*)(ws + WS_Q0); const bf16* KA = (const bf16*)(ws + WS_KA); const bf16* VA = (const bf16*)(ws + WS_VA);
    const bf16* KB = (const bf16*)(ws + WS_KB); const bf16* VB = (const bf16*)(ws + WS_VB); bf16* O = (bf16*)(ws + WS_H);
    const float* lutA = (const float*)(ws + WS_LUTA); const float* lutB = (const float*)(ws + WS_LUTB); const float* sinks = a->in[21];
    constexpr int NI = 512 + 512 + 128 + 128;
    for (int it = BIDX(); it < NI; it += GDIM()) {
        AttnItem A; A.K2 = nullptr; A.rope = nullptr; A.q_stride = 1024; A.scale2 = 0.125f * LOG2E;
        if (it < 1024) {
            const bool isA = it < 512; const int r = it & 511, cgp = r & 31, h = (r >> 5) & 7, b = r >> 8;
            A.Q = Q0 + (isA ? 0 : 512) + h * 64; A.O = O + (isA ? 0 : 512) + h * 64;
            if (isA) { A.K = KA + h * 64; A.V = VA + h * 64; A.k_stride = A.v_stride = 512; A.lut = lutA + h * LUTN; A.m0 = -1.0e30f; A.l0 = 0.f; }
            else { A.K = KB + (h >> 2) * 64; A.V = VB + (h >> 2) * 64; A.k_stride = A.v_stride = 128; A.lut = lutB + h * LUTN; A.m0 = sinks[h] * LOG2E; A.l0 = 1.f; }
            const int prev = isA ? 8 : 2;
            A.q_row0 = b * SEQ + cgp * 512; A.nq_valid = 64; A.k_row0 = b * SEQ; A.q_kidx0 = cgp * 512;
            A.t_lo = max(0, 8 * cgp - prev); A.t_hi = 8 * cgp + 7; A.wlo0 = 8 * cgp - prev; A.whi0 = 8 * cgp; A.wstep_lo = 1; A.wstep = 1; A.nkeys = SEQ;
        } else {
            const bool isA = it < 1152; const int r = (it - 1024) & 127, h = r & 7, b = r >> 3;
            A.Q = Q0 + (isA ? 0 : 512) + h * 64; A.O = O + (isA ? 0 : 512) + h * 64;
            const int nc = isA ? LA : LB;
            if (isA) { A.K = KA + h * 64; A.V = VA + h * 64; A.k_stride = A.v_stride = 512; A.lut = lutA + h * LUTN; A.m0 = -1.0e30f; A.l0 = 0.f; }
            else { A.K = KB + (h >> 2) * 64; A.V = VB + (h >> 2) * 64; A.k_stride = A.v_stride = 128; A.lut = lutB + h * LUTN; A.m0 = sinks[h] * LOG2E; A.l0 = 1.f; }
            A.q_row0 = NPROMPT + b * 32; A.nq_valid = 32; A.k_row0 = NPROMPT + b * (nc + 32); A.q_kidx0 = nc;
            A.nkeys = nc + 32; A.t_lo = 0; A.t_hi = (A.nkeys - 1) >> 6; A.wlo0 = 0; A.whi0 = A.t_hi; A.wstep_lo = 0; A.wstep = -100000;
        }
        attn_item_l0<64, true>(A, lds, wave_s_);
    }
}
__device__ __forceinline__ void attn1_phase(ArgsP a, LAS unsigned char* lds, int wave_s_) {
    unsigned char* ws = a->ws;
    const bf16* QC = (const bf16*)(ws + WS_QC); const bf16* KC = (const bf16*)(ws + WS_KC); const bf16* VC = (const bf16*)(ws + WS_VC); const bf16* KR = (const bf16*)(ws + WS_KR);
    bf16* O = (bf16*)(ws + WS_H);
    constexpr int NI = 1024 + 256;
    for (int it = BIDX(); it < NI; it += GDIM()) {
        AttnItem A; A.q_stride = 1536; A.k_stride = A.v_stride = 1024; A.K2 = KR; A.rope = (const float*)(ws + WS_ROPE); A.lut = nullptr; A.m0 = 0.f; A.l0 = 0.f; A.scale2 = 0.10206207261596577f * LOG2E;
        if (it < 1024) {
            const int j = it >> 8, blk = it & 255, bh = blk & 31, g = blk >> 5, b = bh >> 4, h = bh & 15;
            const int qt = j == 0 ? g : (j == 1 ? 15 - g : (j == 2 ? 16 + g : 31 - g));
            A.Q = QC + h * 96; A.K = KC + h * 64; A.V = VC + h * 64; A.O = O + h * 64;
            A.q_row0 = b * SEQ + qt * 512; A.nq_valid = 64; A.k_row0 = b * SEQ; A.q_kidx0 = qt * 512;
            A.t_lo = 0; A.t_hi = 8 * qt + 7; A.wlo0 = 0; A.whi0 = 8 * qt; A.wstep_lo = 0; A.wstep = 1; A.nkeys = SEQ;
        } else {
            const int r = it - 1024, h = r & 15, b = r >> 4;
            A.Q = QC + h * 96; A.K = KC + h * 64; A.V = VC + h * 64; A.O = O + h * 64;
            A.q_row0 = NPROMPT + b * 32; A.nq_valid = 32; A.k_row0 = NPROMPT + b * (PAST + 32); A.q_kidx0 = PAST;
            A.nkeys = PAST + 32; A.t_lo = 0; A.t_hi = (A.nkeys - 1) >> 6; A.wlo0 = 0; A.whi0 = A.t_hi; A.wstep_lo = 0; A.wstep = -100000;
        }
        if (it < 1024) attn_item<96, false, false>(A, lds, wave_s_); else attn_item<96, false, true>(A, lds, wave_s_);
    }
}

#define XB_TMO      128
#define XB_XCNT(j)  (256  + 64 * (j))
#define XB_XSUB(j)  (1280 + 64 * (j))
#define XB_XGEN(j)  (2304 + 64 * (j))
#define XB_TOP      3328
#define XB_TOPGEN   3392
#define XCD_BAR_WORDS 3456
#define XB_SPIN_CAP (1u << 18)

__device__ __forceinline__ unsigned xb_ld(unsigned* p)              { return __hip_atomic_load(p, __ATOMIC_RELAXED, __HIP_MEMORY_SCOPE_AGENT); }
__device__ __forceinline__ unsigned xb_add(unsigned* p, unsigned v) { return __hip_atomic_fetch_add(p, v, __ATOMIC_RELAXED, __HIP_MEMORY_SCOPE_AGENT); }
__device__ __forceinline__ unsigned xb_xcc_id() { return (unsigned)__builtin_amdgcn_s_getreg((3 << 11) | 20) & 0xFu; }
#define XB_SPIN(cond, bar) do { unsigned _sp = 0; while (cond) { __builtin_amdgcn_s_sleep(1); \
    if ((++_sp & 255u) == 0u) { if (xb_ld(&(bar)[XB_TMO])) break; if (_sp > XB_SPIN_CAP) { atomicAdd(&(bar)[XB_TMO], 1u); break; } } } } while (0)

struct XcdBarrier {
    unsigned* bar; unsigned x;
    volatile LAS unsigned* st;
};

__device__ __forceinline__ XcdBarrier xcd_barrier_post(unsigned* bar, volatile LAS unsigned* st) {
    XcdBarrier b; b.bar = bar; b.x = xb_xcc_id(); b.st = st;
    if (threadIdx.x == 0) (void)xb_add(&bar[XB_XCNT(b.x)], 1u);
    return b;
}
__device__ __forceinline__ void xcd_barrier_complete(unsigned* bar, unsigned x, unsigned& nloc, unsigned& nx) {
    const unsigned G = gridDim.x * gridDim.y * gridDim.z;
    unsigned sum, cnt, mine, sp = 0u;
    for (;;) {
        sum = 0u; cnt = 0u; mine = 0u;
#pragma unroll
        for (unsigned j = 0; j < 16; ++j) { const unsigned c = xb_ld(&bar[XB_XCNT(j)]); sum += c; cnt += (c > 0u) ? 1u : 0u; mine = (j == x) ? c : mine; }
        if (sum == G) break;
        __builtin_amdgcn_s_sleep(1);
        if ((++sp & 255u) == 0u) { if (xb_ld(&bar[XB_TMO])) break; if (sp > XB_SPIN_CAP) { atomicAdd(&bar[XB_TMO], 1u); break; } }
    }
    nloc = mine > 0u ? mine : 1u; nx = cnt > 0u ? cnt : 1u;
}

__device__ __forceinline__ void xcd_barrier(const XcdBarrier& b) {
    asm volatile("s_waitcnt vmcnt(0)" ::: "memory");
    __syncthreads();
    if (threadIdx.x == 0) {
        unsigned* bar = b.bar;
        __builtin_amdgcn_s_waitcnt(0);
        unsigned nloc = b.st[0], nx = b.st[1];
        if (nloc == 0u) { xcd_barrier_complete(bar, b.x, nloc, nx); b.st[0] = nloc; b.st[1] = nx; }
        const unsigned old = xb_add(&bar[XB_XSUB(b.x)], 1u);
        const unsigned gen = old / nloc;
        if (old + 1u == (gen + 1u) * nloc) {
            __builtin_amdgcn_fence(__ATOMIC_RELEASE, "agent");
            asm volatile("s_waitcnt vmcnt(0)" ::: "memory");
            const unsigned og = xb_add(&bar[XB_TOP], 1u);
            const unsigned tg = og / nx;
            if (og + 1u == (tg + 1u) * nx) xb_add(&bar[XB_TOPGEN], 1u);
            else XB_SPIN(xb_ld(&bar[XB_TOPGEN]) == tg, bar);
            __builtin_amdgcn_fence(__ATOMIC_ACQUIRE, "agent");
            xb_add(&bar[XB_XGEN(b.x)], 1u);
            asm volatile("s_waitcnt vmcnt(0)" ::: "memory");
        } else {
            XB_SPIN(xb_ld(&bar[XB_XGEN(b.x)]) == gen, bar);
            __builtin_amdgcn_fence(__ATOMIC_ACQUIRE, "agent");
            asm volatile("s_waitcnt vmcnt(0)" ::: "memory");
        }
    }
    __syncthreads();
}

template <class Epi>
__device__ __forceinline__ void run_gemm(LAS unsigned char* lds, const bf16* A_, const bf16* Bt, int M, int N, int K, const Epi& E, int wave_s_, int Mfull = -1, int nsplit = 1) {
    const int gd = GDIM(), bx = BIDX();
    pg8::Gemm g{A_, Bt, M, N, K}; pg8::StaticOrder S; S.init(M, N, K, gd, bx, Mfull, nsplit);
    pg8::gemm_phase<Epi, pg8::StaticOrder, true, true>(lds, g, S, E, wave_s_);
}
__device__ __forceinline__ void ffn_up_phase(LAS unsigned char* lds, int idx, int wave_s_) {
    ArgsP a = get_args(); unsigned char* ws = a->ws;
    pg8::EpiGU E{(bf16*)(ws + WS_HID)}; run_gemm(lds, (const bf16*)(ws + WS_H), (const bf16*)(ws + WS_WGU + (size_t)idx * SZ_WGU), R, 2 * DFF, DM, E, wave_s_);
}
__device__ __forceinline__ void ffn_down_phase(LAS unsigned char* lds, int idx, int l, int gi, int wave_s_) {
    ArgsP a = get_args(); unsigned char* ws = a->ws;
    pg8::EpiRes E{a->out, ws, (idx == 0 ? a->in[0] : nullptr), gi * DM | (l << 16), 0.5f}; run_gemm(lds, (const bf16*)(ws + WS_HID), (const bf16*)(ws + WS_WD + (size_t)idx * SZ_WD), R, DM, DFF, E, wave_s_, NPROMPT, 11);
}
__device__ __forceinline__ void oproj_phase(LAS unsigned char* lds, int l, int wave_s_) {
    ArgsP a = get_args(); unsigned char* ws = a->ws;
    pg8::EpiRes E{a->out, ws, nullptr, 5 * DM | (l << 16), 1.0f}; run_gemm(lds, (const bf16*)(ws + WS_H), (const bf16*)(ws + (l == 0 ? WS_WOAB : WS_WOC)), R, DM, DM, E, wave_s_, NPROMPT, 4);
}
__device__ __forceinline__ void norm_phase(int l, int which, int wave_s_, bool fold = true) {
    ArgsP a = get_args();
    norm_mod_phase(a, l == 0 && which == 0, a->in[12] + (size_t)(l * 3 + which) * DM, (const float*)(a->ws + WS_MODS) + (size_t)l * NSEQ * NMOD, 3 * which, 3 * which + 1,
                   !fold ? 0 : (which == 2 ? 4 : (l == 0 && which == 0 ? 0 : 11)), wave_s_);
}

__global__ void __launch_bounds__(NT, 2) fwd_megakernel(Args a_unused) {
    extern __shared__ __attribute__((aligned(16))) unsigned char lds_raw[];
    LAS unsigned char* lds = (LAS unsigned char*)lds_raw;
    cg::grid_group grid = cg::this_grid();
    if (threadIdx.x < 4) ((LAS unsigned*)(lds + LDS_BYTES - 16))[threadIdx.x] = 0u;
    __syncthreads();
    (void)xcd_barrier_post((unsigned*)(get_args()->ws + WS_CTL), (volatile LAS unsigned*)(lds + LDS_BYTES - 16));
#define GRID_BAR() do { XcdBarrier b_; b_.bar = (unsigned*)(get_args()->ws + WS_CTL); b_.x = xb_xcc_id(); b_.st = (volatile LAS unsigned*)(lds + LDS_BYTES - 16); xcd_barrier(b_); } while (0)
    const int wave_s_ = __builtin_amdgcn_readfirstlane((int)threadIdx.x >> 6);
    prologue(get_args(), lds, wave_s_);
    grid.sync();
#pragma unroll 1
    for (int l = 0; l < 2; ++l) {
        norm_phase(l, 0, wave_s_); GRID_BAR();
        ffn_up_phase(lds, 2 * l, wave_s_); GRID_BAR();
        ffn_down_phase(lds, 2 * l, l, 2, wave_s_); GRID_BAR();
        norm_phase(l, 1, wave_s_);
        if (l == 0) {
            {
                ArgsP a = get_args(); unsigned char* ws = a->ws; const int gtid = BIDX() * NT + TIDX(), gthreads = GDIM() * NT;
                cvt_rows(a->in[4], (bf16*)(ws + WS_KA), 16, LA, 512, NPROMPT, LA + 32, gtid, gthreads);
                cvt_rows(a->in[5], (bf16*)(ws + WS_VA), 16, LA, 512, NPROMPT, LA + 32, gtid, gthreads);
                cvt_rows(a->in[6], (bf16*)(ws + WS_KB), 16, LB, 128, NPROMPT, LB + 32, gtid, gthreads);
                cvt_rows(a->in[7], (bf16*)(ws + WS_VB), 16, LB, 128, NPROMPT, LB + 32, gtid, gthreads);
                zero16(ws + WS_KA + (size_t)KA_ROWS * 512 * 2, 64 * 512 * 2 / 16, gtid, gthreads); zero16(ws + WS_VA + (size_t)KA_ROWS * 512 * 2, 64 * 512 * 2 / 16, gtid, gthreads);
                zero16(ws + WS_KB + (size_t)KB_ROWS * 128 * 2, 64 * 128 * 2 / 16, gtid, gthreads); zero16(ws + WS_VB + (size_t)KB_ROWS * 128 * 2, 64 * 128 * 2 / 16, gtid, gthreads);
            }
            GRID_BAR();
            {   ArgsP a = get_args(); unsigned char* ws = a->ws;
                pg8::EpiQKV E{(bf16*)(ws + WS_Q0), (bf16*)(ws + WS_KA), (bf16*)(ws + WS_VA), (bf16*)(ws + WS_KB), (bf16*)(ws + WS_VB), a->out};
                run_gemm(lds, (const bf16*)(ws + WS_H), (const bf16*)(ws + WS_WAB), R, 2304, DM, E, wave_s_); }
            GRID_BAR();
            attn0_phase(get_args(), lds, wave_s_);
            GRID_BAR();
        } else {
            prologue_l1(get_args(), wave_s_);
            GRID_BAR();
            {   ArgsP a = get_args(); unsigned char* ws = a->ws;
                pg8::EpiF32 E{(float*)(ws + WS_CIN), 768}; run_gemm(lds, (const bf16*)(ws + WS_H), (const bf16*)(ws + WS_WCIN), R, 768, DM, E, wave_s_); }
            GRID_BAR();
            mla_norm_phase(get_args(), wave_s_);
            GRID_BAR();
            {   ArgsP a = get_args(); unsigned char* ws = a->ws; const int gtid = BIDX() * NT + TIDX(), gthreads = GDIM() * NT;
                zero16(ws + WS_KC + (size_t)RKV * 1024 * 2, 64 * 1024 * 2 / 16, gtid, gthreads); zero16(ws + WS_VC + (size_t)RKV * 1024 * 2, 64 * 1024 * 2 / 16, gtid, gthreads); }
            {   ArgsP a = get_args(); unsigned char* ws = a->ws;
                pg8::EpiBF E{(bf16*)(ws + WS_QC), 1536}; run_gemm(lds, (const bf16*)(ws + WS_QN), (const bf16*)(ws + WS_WQB), R, 1536, 384, E, wave_s_); }
            {   ArgsP a = get_args(); unsigned char* ws = a->ws;
                pg8::EpiKV E{(bf16*)(ws + WS_KC), (bf16*)(ws + WS_VC)}; run_gemm(lds, (const bf16*)(ws + WS_KVN), (const bf16*)(ws + WS_WKVB), RKV, 2048, 256, E, wave_s_); }
            GRID_BAR();
            attn1_phase(get_args(), lds, wave_s_);
            GRID_BAR();
        }
        oproj_phase(lds, l, wave_s_); GRID_BAR();
        norm_phase(l, 2, wave_s_); GRID_BAR();
        ffn_up_phase(lds, 2 * l + 1, wave_s_); GRID_BAR();
        ffn_down_phase(lds, 2 * l + 1, l, 8, wave_s_); GRID_BAR();
    }
    final_norm_phase(get_args(), wave_s_);
}

extern "C" void kernel_launch(void* const* d_in, const int* in_sizes, int n_in, void* d_out, int out_size, void* d_ws, size_t ws_size, hipStream_t stream) {
    static int grid = 0;
    if (grid == 0) {
        if (n_in != 28 || out_size != (int)O_END || ws_size < WS_CTL + 16384) { fprintf(stderr, "kernel_launch: unexpected shapes n_in %d out %d ws %zu (need %zu)\n", n_in, out_size, ws_size, (size_t)(WS_CTL + 16384)); grid = -1; return; }
        int dev = 0, cus = 0, per_cu = 0;
        hipGetDevice(&dev); hipDeviceGetAttribute(&cus, hipDeviceAttributeMultiprocessorCount, dev);
        if (hipFuncSetAttribute((const void*)fwd_megakernel, hipFuncAttributeMaxDynamicSharedMemorySize, LDS_BYTES) != hipSuccess) { fprintf(stderr, "kernel_launch: hipFuncSetAttribute failed\n"); grid = -1; return; }
        if (hipOccupancyMaxActiveBlocksPerMultiprocessor(&per_cu, (const void*)fwd_megakernel, NT, LDS_BYTES) != hipSuccess || per_cu < 1) { fprintf(stderr, "kernel_launch: occupancy query says %d\n", per_cu); per_cu = 1; }
        (void)hipGetLastError();
        grid = cus;
    }
    if (grid < 0) return;
    if (hipMemsetAsync((char*)d_ws + WS_CTL, 0, XCD_BAR_WORDS * 4, stream) != hipSuccess) { fprintf(stderr, "kernel_launch: hipMemsetAsync failed\n"); return; }
    Args a{};
    for (int i = 0; i < 28; ++i) a.in[i] = (const float*)d_in[i];
    a.out = (float*)d_out; a.ws = (unsigned char*)d_ws;
    void* args[] = {&a};
    hipError_t e = hipLaunchCooperativeKernel((const void*)fwd_megakernel, dim3(grid), dim3(NT), args, LDS_BYTES, stream);
    if (e != hipSuccess) fprintf(stderr, "cooperative launch failed: %s (grid %d)\n", hipGetErrorString(e), grid);
}
```
